# Optimizing an MI355X kernel written in HIP

```python
import math
import jax
import jax.numpy as jnp
from jax import lax
import numpy as np

D_MODEL = 1024
BATCH = 8
SEQ = 8192
DEPTH = 1
DEC_BATCH = 16
DEC_SEQ = 16
PAST_LEN = 2048

CHUNK = 64
PLE_DIM = 256
H_A = 8
DK = 64
DV = 64
W_A = H_A * DV
QKV_A = 2 * H_A * DK + H_A * DV
CONV_W = 4
H_B = 8
D_B = 64
W_B = H_B * D_B
LEFT_CHUNKS = 8
BAND_PAST = LEFT_CHUNKS * CHUNK
MAX_REL = 128
N_REL = 2 * MAX_REL + 1
D_MIX = W_A + W_B
SPLIT_SIZES = (QKV_A, H_A, H_A, W_A, W_B, W_B, W_B, W_B)
D_PROJ = sum(SPLIT_SIZES)
EPS = 1e-6

kernel_name = 'hybrid_gdn_chunkband_streaming_step'


def rms_norm(x, g):
    xf = x.astype(jnp.float32)
    y = xf * lax.rsqrt(jnp.mean(xf * xf, axis=-1, keepdims=True) + EPS)
    return (y * g.astype(jnp.float32)).astype(x.dtype)


def l2_norm(x):
    xf = x.astype(jnp.float32)
    return (xf * lax.rsqrt(jnp.sum(xf * xf, axis=-1, keepdims=True) + EPS)).astype(x.dtype)


def _gated_delta_blocked(q, k, v, g, beta, s0):
    b, t, h, _ = q.shape
    dv = v.shape[-1]
    out_dtype, st_dtype = v.dtype, s0.dtype
    blen = min(CHUNK, t)
    n = t // blen
    f32 = jnp.float32

    def blk(a):
        return a.astype(f32).reshape(b, n, blen, h, -1).transpose(0, 3, 1, 2, 4)

    q, k, v = blk(q), blk(k), blk(v)
    g = g.astype(f32).reshape(b, n, blen, h).transpose(0, 3, 1, 2)
    beta = beta.astype(f32).reshape(b, n, blen, h).transpose(0, 3, 1, 2)
    gc = jnp.cumsum(g, axis=-1)
    incl = jnp.tril(jnp.ones((blen, blen), bool))
    strict = jnp.tril(jnp.ones((blen, blen), bool), -1)
    decay = jnp.exp(jnp.where(incl, gc[..., :, None] - gc[..., None, :], -jnp.inf))
    kk = jnp.einsum('bhnid,bhnjd->bhnij', k, k)
    lower = jnp.where(strict, beta[..., :, None] * kk * decay, 0.0) + jnp.eye(blen, dtype=f32)
    rhs = jnp.concatenate([v * beta[..., None], k * (beta * jnp.exp(gc))[..., None]], axis=-1)
    sol = lax.linalg.triangular_solve(lower, rhs, left_side=True, lower=True)
    u, w = sol[..., :dv], sol[..., dv:]
    qk = jnp.einsum('bhnid,bhnjd->bhnij', q, k) * decay
    q_dec = q * jnp.exp(gc)[..., None]
    k_tail = k * jnp.exp(gc[..., -1:] - gc)[..., None]
    g_tot = jnp.exp(gc[..., -1])

    def step(s, xs):
        u_c, w_c, qk_c, qd_c, kt_c, gt_c = xs
        v_new = u_c - jnp.einsum('bhld,bhde->bhle', w_c, s)
        o_c = jnp.einsum('bhld,bhde->bhle', qd_c, s) + jnp.einsum('bhij,bhje->bhie', qk_c, v_new)
        s = s * gt_c[..., None, None] + jnp.einsum('bhld,bhle->bhde', kt_c, v_new)
        return s, o_c

    xs = tuple(jnp.moveaxis(a, 2, 0) for a in (u, w, qk, q_dec, k_tail, g_tot))
    s_fin, o = lax.scan(step, s0.astype(f32), xs)
    o = o.transpose(1, 0, 3, 2, 4).reshape(b, t, h, dv)
    return o.astype(out_dtype), s_fin.astype(st_dtype)


def _rel_bias(table, qpos, kpos):
    rel = jnp.clip(qpos[:, None] - kpos[None, :], -MAX_REL, MAX_REL) + MAX_REL
    return table[:, rel].astype(jnp.float32)


def _softmax_attend(q, k, v, bias, valid=None):
    s = jnp.einsum('bqhd,bkhd->bhqk', q, k).astype(jnp.float32) * (D_B ** -0.5) + bias
    if valid is not None:
        s = jnp.where(valid, s, -jnp.inf)
    p = jax.nn.softmax(s, axis=-1)
    return jnp.einsum('bhqk,bkhd->bqhd', p.astype(v.dtype), v)


def _band_attention_prompt(q, k, v, table):
    b, t, h, d = q.shape
    n = t // CHUNK
    span = BAND_PAST + CHUNK
    kpad = jnp.pad(k, ((0, 0), (BAND_PAST, 0), (0, 0), (0, 0)))
    vpad = jnp.pad(v, ((0, 0), (BAND_PAST, 0), (0, 0), (0, 0)))
    bias = _rel_bias(table, BAND_PAST + jnp.arange(CHUNK), jnp.arange(span))
    qc = jnp.moveaxis(q.reshape(b, n, CHUNK, h, d), 1, 0)

    def one(args):
        c, qb = args
        start = c * CHUNK
        kb = lax.dynamic_slice_in_dim(kpad, start, span, axis=1)
        vb = lax.dynamic_slice_in_dim(vpad, start, span, axis=1)
        valid = (start + jnp.arange(span)) >= BAND_PAST
        return _softmax_attend(qb, kb, vb, bias, valid)

    o = lax.map(one, (jnp.arange(n), qc))
    return jnp.moveaxis(o, 0, 1).reshape(b, t, h, d)


def _band_attention_sample(q, k_new, v_new, k_cache, v_cache, table):
    wc = k_cache.shape[1]
    tn = q.shape[1]
    kb = jnp.concatenate([k_cache, k_new], axis=1)
    vb = jnp.concatenate([v_cache, v_new], axis=1)
    bias = _rel_bias(table, wc + jnp.arange(tn), jnp.arange(wc + tn))
    return _softmax_attend(q, kb, vb, bias)


def _layer(h, p_i, conv0, s0, k_cache, v_cache, ln_g, w_in, conv_w, a_log, dt_bias,
           gdn_norm_g, q_norm_g, k_norm_g, rel_bias, w_out, w_ple_proj, ple_norm_g, w_ple_gate):
    b, t, _ = h.shape
    xn = rms_norm(h, ln_g)
    proj = xn @ w_in
    split_at = np.cumsum(SPLIT_SIZES)[:-1].tolist()
    qkv_a, a_raw, b_raw, z_a, q_b, k_b, v_b, z_b = jnp.split(proj, split_at, axis=-1)

    xcat = jnp.concatenate([conv0, qkv_a], axis=1)
    conv = sum(xcat[:, j:j + t] * conv_w[j] for j in range(CONV_W))
    new_conv = xcat[:, xcat.shape[1] - (CONV_W - 1):]
    conv = jax.nn.silu(conv)
    q_a, k_a, v_a = jnp.split(conv, [H_A * DK, 2 * H_A * DK], axis=-1)
    q_a = l2_norm(q_a.reshape(b, t, H_A, DK)) * (DK ** -0.5)
    k_a = l2_norm(k_a.reshape(b, t, H_A, DK))
    v_a = v_a.reshape(b, t, H_A, DV)
    beta = jax.nn.sigmoid(b_raw.astype(jnp.float32))
    g = -jnp.exp(a_log.astype(jnp.float32)) * jax.nn.softplus(
        a_raw.astype(jnp.float32) + dt_bias.astype(jnp.float32))
    o_a, s_new = _gated_delta_blocked(q_a, k_a, v_a, g, beta, s0)
    o_a = rms_norm(o_a, gdn_norm_g).reshape(b, t, W_A) * jax.nn.silu(z_a)

    q_b = rms_norm(q_b.reshape(b, t, H_B, D_B), q_norm_g)
    k_b = rms_norm(k_b.reshape(b, t, H_B, D_B), k_norm_g)
    v_b = v_b.reshape(b, t, H_B, D_B)
    if k_cache is None:
        o_b = _band_attention_prompt(q_b, k_b, v_b, rel_bias)
        keep = min(BAND_PAST, t)
        k_state, v_state = k_b[:, t - keep:], v_b[:, t - keep:]
    else:
        o_b = _band_attention_sample(q_b, k_b, v_b, k_cache, v_cache, rel_bias)
        k_state, v_state = k_b, v_b
    o_b = o_b.reshape(b, t, W_B) * jax.nn.silu(z_b)

    h = h + jnp.concatenate([o_a, o_b], axis=-1) @ w_out
    e = rms_norm(p_i @ w_ple_proj, ple_norm_g)
    h = h + jax.nn.sigmoid(h @ w_ple_gate) * e
    return h, new_conv, s_new, k_state, v_state


def setup_inputs(seed: int = 0) -> dict:
    key = jax.random.key(seed)
    ks = jax.random.split(key, 24)
    f32 = jnp.float32

    def nrm(k, shape, s):
        return jax.random.normal(k, shape, f32) * s

    wc = min(BAND_PAST, PAST_LEN)
    dt = jnp.exp(jax.random.uniform(ks[12], (DEPTH, H_A), f32, math.log(1e-3), math.log(1e-1)))
    return {
        'x_prompt': nrm(ks[0], (BATCH, SEQ, D_MODEL), 1.0),
        'x_sample': nrm(ks[1], (DEC_BATCH, DEC_SEQ, D_MODEL), 1.0),
        'state_conv': nrm(ks[2], (DEPTH, DEC_BATCH, CONV_W - 1, QKV_A), 1.0),
        'state_gdn': nrm(ks[3], (DEPTH, DEC_BATCH, H_A, DK, DV), 0.3),
        'cache_k': nrm(ks[4], (DEPTH, DEC_BATCH, wc, H_B, D_B), 1.0),
        'cache_v': nrm(ks[5], (DEPTH, DEC_BATCH, wc, H_B, D_B), 1.0),
        'p_prompt': nrm(ks[6], (DEPTH, BATCH, SEQ, PLE_DIM), 1.0),
        'p_sample': nrm(ks[7], (DEPTH, DEC_BATCH, DEC_SEQ, PLE_DIM), 1.0),
        'ln_g': 1.0 + nrm(ks[8], (DEPTH, D_MODEL), 0.05),
        'w_in': nrm(ks[9], (DEPTH, D_MODEL, D_PROJ), D_MODEL ** -0.5),
        'conv_w': nrm(ks[10], (DEPTH, CONV_W, QKV_A), CONV_W ** -0.5),
        'a_log': jnp.log(jax.random.uniform(ks[11], (DEPTH, H_A), f32, 1.0, 16.0)),
        'dt_bias': dt + jnp.log(-jnp.expm1(-dt)),
        'gdn_norm_g': 1.0 + nrm(ks[13], (DEPTH, DV), 0.05),
        'q_norm_g': 1.0 + nrm(ks[14], (DEPTH, D_B), 0.05),
        'k_norm_g': 1.0 + nrm(ks[15], (DEPTH, D_B), 0.05),
        'rel_bias': nrm(ks[16], (DEPTH, H_B, N_REL), 0.5),
        'w_out': nrm(ks[17], (DEPTH, D_MIX, D_MODEL), D_MIX ** -0.5),
        'w_ple_proj': nrm(ks[18], (DEPTH, PLE_DIM, D_MODEL), PLE_DIM ** -0.5),
        'ple_norm_g': 1.0 + nrm(ks[19], (DEPTH, D_MODEL), 0.05),
        'w_ple_gate': nrm(ks[20], (DEPTH, D_MODEL, D_MODEL), D_MODEL ** -0.5),
    }


def reference(x_prompt, x_sample, state_conv, state_gdn, cache_k, cache_v, p_prompt, p_sample,
              ln_g, w_in, conv_w, a_log, dt_bias, gdn_norm_g, q_norm_g, k_norm_g, rel_bias,
              w_out, w_ple_proj, ple_norm_g, w_ple_gate):
    hp, hs = x_prompt, x_sample
    bp = x_prompt.shape[0]
    conv_p, gdn_p, kp, vp = [], [], [], []
    conv_s, gdn_s, ksm, vsm = [], [], [], []
    for i in range(DEPTH):
        w_i = (ln_g[i], w_in[i], conv_w[i], a_log[i], dt_bias[i], gdn_norm_g[i], q_norm_g[i],
               k_norm_g[i], rel_bias[i], w_out[i], w_ple_proj[i], ple_norm_g[i], w_ple_gate[i])
        conv0 = jnp.zeros((bp, CONV_W - 1, QKV_A), x_prompt.dtype)
        s0 = jnp.zeros((bp, H_A, DK, DV), x_prompt.dtype)
        hp, c_p, g_p, k_p, v_p = _layer(hp, p_prompt[i], conv0, s0, None, None, *w_i)
        hs, c_s, g_s, k_s, v_s = _layer(hs, p_sample[i], state_conv[i], state_gdn[i],
                                        cache_k[i], cache_v[i], *w_i)
        conv_p.append(c_p); gdn_p.append(g_p); kp.append(k_p); vp.append(v_p)
        conv_s.append(c_s); gdn_s.append(g_s); ksm.append(k_s); vsm.append(v_s)
    conv_prompt = jnp.stack(conv_p)
    gdn_prompt = jnp.stack(gdn_p)
    k_prompt = jnp.stack(kp)
    v_prompt = jnp.stack(vp)
    conv_sample = jnp.stack(conv_s)
    gdn_sample = jnp.stack(gdn_s)
    k_sample = jnp.stack(ksm)
    v_sample = jnp.stack(vsm)
    return (hp, hs, conv_prompt, gdn_prompt, k_prompt, v_prompt,
            conv_sample, gdn_sample, k_sample, v_sample)
```

```cpp
#include <hip/hip_runtime.h>
#include <cstdio>
#include <cstdint>
#ifndef MK_N_LAUNCHES
#define MK_N_LAUNCHES 1
#endif
namespace pg8 {
#define PG8_LAS __attribute__((address_space(3)))
typedef unsigned short bf16_t;
typedef short bf16x8 __attribute__((ext_vector_type(8)));
typedef float f32x4 __attribute__((ext_vector_type(4)));
typedef unsigned u32x4 __attribute__((ext_vector_type(4)));
constexpr int BM = 256, BK = 64, HALF = 128, HTB = HALF * BK * 2  , STAGE_BYTES = 8 * HTB, NXCD = 8, WGM = 8;

__host__ __device__ __forceinline__ int lds_byte(int r, int c) { const int st = (r >> 4) * 2 + (c >> 5), rr = r & 15, cc = c & 31, ob = rr * 64 + cc * 2; return st * 1024 + (ob ^ (((ob >> 9) & 1) << 5)); }
__host__ __device__ __forceinline__ void stage_rc(int b, int& R, int& C) { const int st = b / 1024, sb = b % 1024, swz = sb ^ (((sb >> 9) & 1) << 5); R = (st >> 1) * 16 + swz / 64; C = (st & 1) * 32 + (swz % 64) / 2; }
__host__ __device__ __forceinline__ int perm32(int rho) { const int n = rho >> 4, i = rho & 15; return 8 * (i >> 2) + 4 * n + (i & 3); }

struct Unit { int pm, pn; };
struct Gemm { const bf16_t* A; const bf16_t* Bt; int M, N, K; };

struct StaticOrder {
    int nM, nN, nwg, G, c;
    __host__ __device__ void init(int M, int N, int G_, int c_) { nM = M / BM; nN = N / BM; nwg = nM * nN; G = G_; c = c_; }
    __host__ __device__ bool next(int i, Unit& u) const {
        const long L = (long)i * G + c; if (L >= nwg) return false;
        int wgid = (int)L; { const int q = nwg / NXCD, r = nwg % NXCD, xcd = wgid % NXCD, off = wgid / NXCD; wgid = (xcd < r ? xcd * (q + 1) : r * (q + 1) + (xcd - r) * q) + off; }
        const int nig = WGM * nN, gid = wgid / nig, fm = gid * WGM, gsz = (nM - fm) < WGM ? (nM - fm) : WGM;
        u.pm = fm + ((wgid % nig) % gsz); u.pn = (wgid % nig) / gsz; return true;
    }
    __device__ __forceinline__ void a_ready(const Unit&) const {}
    __device__ __forceinline__ void done(const Unit&) const {}
};

typedef float f32x2c __attribute__((ext_vector_type(2))); typedef __bf16 bf16x2c __attribute__((ext_vector_type(2)));
__device__ __forceinline__ unsigned cvt_pk_bf16_v(float lo, float hi) { const f32x2c v = {lo, hi}; const bf16x2c b = __builtin_convertvector(v, bf16x2c); return __builtin_bit_cast(unsigned, b); }
__device__ __forceinline__ unsigned cvt_pk_bf16(float lo, float hi) { unsigned r; asm volatile("v_cvt_pk_bf16_f32 %0, %1, %2" : "=v"(r) : "v"(lo), "v"(hi)); return r; }
typedef unsigned u32x2 __attribute__((ext_vector_type(2)));
struct EpiProj {
    static constexpr bool PERM = true, AFTER_DRAIN = false;
    bf16_t* qkva; bf16_t* qkvb; bf16_t* z;
    __device__ __forceinline__ void operator()(const f32x4 (&acc)[2][2][4][2], const Unit& u_, int wr, int wc, int fr, int fq) const {
        Unit u = u_; asm volatile("" : "+s"(u.pm), "+s"(u.pn));
        bf16_t* base; int ldc, colt;
        if (u.pn < 6) { base = qkva; ldc = 1536; colt = u.pn * 256; }
        else if (u.pn < 12) { base = qkvb; ldc = 1536; colt = (u.pn - 6) * 256; }
        else { base = z; ldc = 1024; colt = (u.pn - 12) * 256; }
        const int row0 = u.pm * BM + wr * 64 + fr; const int col0 = colt + wc * 32 + 8 * fq;
#pragma unroll
        for (int ai = 0; ai < 2; ++ai)
#pragma unroll
            for (int m = 0; m < 4; ++m) { bf16_t* rowp = base + (size_t)(row0 + ai * HALF + m * 16) * ldc + col0;
#pragma unroll
                for (int bj = 0; bj < 2; ++bj) { const f32x4 v0 = acc[ai][bj][m][0], v1 = acc[ai][bj][m][1];
                    u32x4 w; w.x = cvt_pk_bf16(v0[0], v0[1]); w.y = cvt_pk_bf16(v0[2], v0[3]); w.z = cvt_pk_bf16(v1[0], v1[1]); w.w = cvt_pk_bf16(v1[2], v1[3]);
                    *(u32x4*)(rowp + bj * HALF) = w; } }
    }
};
struct EpiE {
    static constexpr bool PERM = true, AFTER_DRAIN = false;
    bf16_t* E; float* ssq;
    __device__ __forceinline__ void operator()(const f32x4 (&acc)[2][2][4][2], const Unit& u_, int wr, int wc, int fr, int fq) const {
        Unit u = u_; asm volatile("" : "+s"(u.pm), "+s"(u.pn));
        const int row0 = u.pm * BM + wr * 64 + fr; const int col0 = u.pn * BM + wc * 32 + 8 * fq;
#pragma unroll
        for (int ai = 0; ai < 2; ++ai)
#pragma unroll
            for (int m = 0; m < 4; ++m) { const int row = row0 + ai * HALF + m * 16; bf16_t* rowp = E + (size_t)row * 1024 + col0; float s = 0.f;
#pragma unroll
                for (int bj = 0; bj < 2; ++bj) { const f32x4 v0 = acc[ai][bj][m][0], v1 = acc[ai][bj][m][1];
                    s += (v0[0] * v0[0] + v0[1] * v0[1]) + (v0[2] * v0[2] + v0[3] * v0[3]) + (v1[0] * v1[0] + v1[1] * v1[1]) + (v1[2] * v1[2] + v1[3] * v1[3]);
                    u32x4 w; w.x = cvt_pk_bf16(v0[0], v0[1]); w.y = cvt_pk_bf16(v0[2], v0[3]); w.z = cvt_pk_bf16(v1[0], v1[1]); w.w = cvt_pk_bf16(v1[2], v1[3]);
                    *(u32x4*)(rowp + bj * HALF) = w; }
                s += __shfl_xor(s, 16); s += __shfl_xor(s, 32);
                if (fq == 0) atomicAdd(ssq + row, s);
                asm volatile("" ::: "memory"); }
    }
};
struct EpiOut {
    static constexpr bool PERM = false, AFTER_DRAIN = false;
    const float* xp; const float* xs; float* y; bf16_t* h1b;
    __device__ __forceinline__ void operator()(const f32x4 (&acc)[2][2][4][2], const Unit& u_, int wr, int wc, int fr, int fq) const {
        Unit u = u_; asm volatile("" : "+s"(u.pm), "+s"(u.pn));
        const int col0 = u.pn * BM + wc * 32 + 4 * fq;
#pragma unroll
        for (int ai = 0; ai < 2; ++ai)
#pragma unroll
            for (int m = 0; m < 4; ++m) { const int row = u.pm * BM + ai * HALF + wr * 64 + m * 16 + fr;
                const float* xrow = (u.pm < 256) ? xp + (size_t)row * 1024 : xs + (size_t)(row - 65536) * 1024;
#pragma unroll
                for (int bj = 0; bj < 2; ++bj)
#pragma unroll
                    for (int n = 0; n < 2; ++n) { const int col = col0 + bj * HALF + n * 16;
                        const f32x4 h = *(const f32x4*)(xrow + col) + acc[ai][bj][m][n];
                        *(f32x4*)(y + (size_t)row * 1024 + col) = h;
                        u32x2 w; w.x = cvt_pk_bf16(h[0], h[1]); w.y = cvt_pk_bf16(h[2], h[3]); *(u32x2*)(h1b + (size_t)row * 1024 + col) = w; }
                if (m & 1) asm volatile("" ::: "memory"); }
    }
};
struct EpiGate {
    static constexpr bool PERM = false, AFTER_DRAIN = false;
    float* y; const bf16_t* E; const float* ssq; const float* pg;
    __device__ __forceinline__ void operator()(const f32x4 (&acc)[2][2][4][2], const Unit& u_, int wr, int wc, int fr, int fq) const {
        Unit u = u_; asm volatile("" : "+s"(u.pm), "+s"(u.pn));
        const int col0 = u.pn * BM + wc * 32 + 4 * fq;
        f32x4 g4[2][2];
#pragma unroll
        for (int bj = 0; bj < 2; ++bj)
#pragma unroll
            for (int n = 0; n < 2; ++n) g4[bj][n] = *(const f32x4*)(pg + col0 + bj * HALF + n * 16);
#pragma unroll
        for (int ai = 0; ai < 2; ++ai)
#pragma unroll
            for (int m = 0; m < 4; ++m) { const int row = u.pm * BM + ai * HALF + wr * 64 + m * 16 + fr;
                const float rstd = __builtin_amdgcn_rsqf(ssq[row] * (1.0f / 1024.0f) + 1e-6f);
#pragma unroll
                for (int bj = 0; bj < 2; ++bj)
#pragma unroll
                    for (int n = 0; n < 2; ++n) { const int col = col0 + bj * HALF + n * 16; const size_t off = (size_t)row * 1024 + col;
                        const f32x4 h = *(const f32x4*)(y + off); const u32x2 eb = *(const u32x2*)(E + off); const f32x4 a = acc[ai][bj][m][n];
                        f32x4 e; e[0] = __uint_as_float(eb.x << 16); e[1] = __uint_as_float(eb.x & 0xffff0000u); e[2] = __uint_as_float(eb.y << 16); e[3] = __uint_as_float(eb.y & 0xffff0000u);
                        f32x4 o;
#pragma unroll
                        for (int i = 0; i < 4; ++i) { const float sg = __builtin_amdgcn_rcpf(1.0f + __expf(-a[i])); o[i] = h[i] + sg * (e[i] * rstd * g4[bj][n][i]); }
                        *(f32x4*)(y + off) = o; }
                if (m & 1) asm volatile("" ::: "memory"); }
    }
};
struct PanelOrder { int pm, n;
    __device__ __forceinline__ bool next(int i, Unit& u) const { if (i >= n) return false; u.pm = pm; u.pn = i; return true; }
    __device__ __forceinline__ void a_ready(const Unit&) const {}
    __device__ __forceinline__ void done(const Unit&) const {} };
struct EpiOutB {
    static constexpr bool PERM = true, AFTER_DRAIN = false;
    const float* xp; bf16_t* h1b;
    __device__ __forceinline__ void operator()(const f32x4 (&acc)[2][2][4][2], const Unit& u_, int wr, int wc, int fr, int fq) const {
        Unit u = u_; asm volatile("" : "+s"(u.pm), "+s"(u.pn));
        const int row0 = u.pm * BM + wr * 64 + fr; const int col0 = u.pn * BM + wc * 32 + 8 * fq;
#pragma unroll
        for (int ai = 0; ai < 2; ++ai)
#pragma unroll
            for (int m = 0; m < 4; ++m) { const size_t off = (size_t)(row0 + ai * HALF + m * 16) * 1024 + col0;
#pragma unroll
                for (int bj = 0; bj < 2; ++bj) { const f32x4 x0 = *(const f32x4*)(xp + off + bj * HALF), x1 = *(const f32x4*)(xp + off + bj * HALF + 4);
                    const f32x4 v0 = acc[ai][bj][m][0] + x0, v1 = acc[ai][bj][m][1] + x1;
                    u32x4 w; w.x = cvt_pk_bf16(v0[0], v0[1]); w.y = cvt_pk_bf16(v0[2], v0[3]); w.z = cvt_pk_bf16(v1[0], v1[1]); w.w = cvt_pk_bf16(v1[2], v1[3]);
                    *(u32x4*)(h1b + off + bj * HALF) = w; }
                if (m & 1) asm volatile("" ::: "memory"); }
    }
};
struct EpiGateB {
    static constexpr bool PERM = true, AFTER_DRAIN = false;
    float* y; const bf16_t* h1b; const bf16_t* E; const float* ssq; const float* pg;
    __device__ __forceinline__ void operator()(const f32x4 (&acc)[2][2][4][2], const Unit& u_, int wr, int wc, int fr, int fq) const {
        Unit u = u_; asm volatile("" : "+s"(u.pm), "+s"(u.pn));
        const int row0 = u.pm * BM + wr * 64 + fr; const int col0 = u.pn * BM + wc * 32 + 8 * fq;
        f32x4 g4[2][2];
#pragma unroll
        for (int bj = 0; bj < 2; ++bj)
#pragma unroll
            for (int n = 0; n < 2; ++n) g4[bj][n] = *(const f32x4*)(pg + col0 + bj * HALF + 4 * n);
#pragma unroll
        for (int ai = 0; ai < 2; ++ai)
#pragma unroll
            for (int m = 0; m < 4; ++m) { const int row = row0 + ai * HALF + m * 16; const size_t off = (size_t)row * 1024 + col0;
                const float rstd = __builtin_amdgcn_rsqf(ssq[row] * (1.0f / 1024.0f) + 1e-6f);
#pragma unroll
                for (int bj = 0; bj < 2; ++bj) { const u32x4 hb = *(const u32x4*)(h1b + off + bj * HALF), eb = *(const u32x4*)(E + off + bj * HALF);
                    const unsigned hw[4] = {hb.x, hb.y, hb.z, hb.w}, ew[4] = {eb.x, eb.y, eb.z, eb.w};
                    f32x4 o[2];
#pragma unroll
                    for (int i = 0; i < 8; ++i) { const float h = (i & 1) ? __uint_as_float(hw[i >> 1] & 0xffff0000u) : __uint_as_float(hw[i >> 1] << 16);
                        const float ee = (i & 1) ? __uint_as_float(ew[i >> 1] & 0xffff0000u) : __uint_as_float(ew[i >> 1] << 16);
                        const float a = acc[ai][bj][m][i >> 2][i & 3]; const float sg = __builtin_amdgcn_rcpf(1.0f + __expf(-a));
                        o[i >> 2][i & 3] = h + sg * (ee * rstd * g4[bj][i >> 2][i & 3]); }
                    *(f32x4*)(y + off + bj * HALF) = o[0]; *(f32x4*)(y + off + bj * HALF + 4) = o[1]; }
                if (m & 1) asm volatile("" ::: "memory"); }
    }
};
template <class Epi, class Sched, bool ALIGN_EPI = false, bool SP2 = false>
__device__ __forceinline__ void gemm_phase(PG8_LAS unsigned char* lds, const Gemm g, const Sched& S, const Epi& E) {
    int tid_l = threadIdx.x; asm volatile("" : "+v"(tid_l));
    const int tid = tid_l, wid = __builtin_amdgcn_readfirstlane(tid >> 6), lane = tid & 63, wr = wid >> 2, wc = wid & 3, fr = lane & 15, fq = lane >> 4;
    const int K = g.K, nt = K / BK;
    unsigned voffA[2], voffB[2];
#pragma unroll
    for (int i = 0; i < 2; ++i) { int R, C; stage_rc(tid * 16 + i * 8192, R, C); const int Rb = Epi::PERM ? ((R & ~31) + perm32(R & 31)) : R;
        voffA[i] = (unsigned)(R * K + C) * 2u; voffB[i] = (unsigned)(Rb * K + C) * 2u; }
    const size_t kstep = (size_t)(BK * 2);
    const size_t hstep = (size_t)HALF * K * 2;
    const size_t tstep = 2 * hstep;
    const unsigned ldsw = (unsigned)wid * 1024u;
    const int aoff = lds_byte(wr * 64 + fr, fq * 8), boff = lds_byte(wc * 32 + fr, fq * 8);
#define PG8_SA(b, h) (((b) * 2 + (h)) * HTB)
#define PG8_SB(b, h) ((4 + (b) * 2 + (h)) * HTB)
#define PG8_STAGE(bufoff, gbase, voff) do { _Pragma("unroll") for (int _i = 0; _i < 2; ++_i) \
        __builtin_amdgcn_global_load_lds((const unsigned*)((const char*)(gbase) + (voff)[_i]), (PG8_LAS unsigned*)(lds + (bufoff) + ldsw + _i * 8192), 16, 0, 0); } while (0)
#define PG8_LDA(dst, b, h) do { _Pragma("unroll") for (int m = 0; m < 4; ++m) _Pragma("unroll") for (int k = 0; k < 2; ++k) dst[m][k] = *(const PG8_LAS bf16x8*)(lds + PG8_SA(b, h) + aoff + m * 2048 + k * 1024); } while (0)
#define PG8_LDB(dst, b, h) do { _Pragma("unroll") for (int n = 0; n < 2; ++n) _Pragma("unroll") for (int k = 0; k < 2; ++k) dst[n][k] = *(const PG8_LAS bf16x8*)(lds + PG8_SB(b, h) + boff + n * 2048 + k * 1024); } while (0)
#define PG8_MMA(ai, bj, At, Bt) do { __builtin_amdgcn_s_setprio(1); _Pragma("unroll") for (int m = 0; m < 4; ++m) _Pragma("unroll") for (int n = 0; n < 2; ++n) _Pragma("unroll") for (int k = 0; k < 2; ++k) \
        acc[ai][bj][m][n] = __builtin_amdgcn_mfma_f32_16x16x32_bf16(Bt[n][k], At[m][k], acc[ai][bj][m][n], 0, 0, 0); __builtin_amdgcn_s_setprio(0); } while (0)
#define PG8_WAIT_V(n) asm volatile("s_waitcnt vmcnt(" #n ")" ::: "memory")
#define PG8_WAIT_L(n) asm volatile("s_waitcnt lgkmcnt(" #n ")" ::: "memory")
#define PG8_BAR __builtin_amdgcn_s_barrier()
#define PG8_SCHED __builtin_amdgcn_sched_barrier(0)
    Unit cur, nxt; int ui = 0;
    if (!S.next(0, cur)) return;
    f32x4 acc[2][2][4][2];
#pragma unroll
    for (int a = 0; a < 2; ++a)
#pragma unroll
        for (int b = 0; b < 2; ++b)
#pragma unroll
            for (int m = 0; m < 4; ++m)
#pragma unroll
                for (int n = 0; n < 2; ++n) acc[a][b][m][n] = (f32x4){0.f, 0.f, 0.f, 0.f};
    bf16x8 At[4][2], B0[2][2], B1[2][2];
    const char* cA = (const char*)g.A + (size_t)cur.pm * tstep; const char* cB = (const char*)g.Bt + (size_t)cur.pn * tstep;
    S.a_ready(cur);
    if constexpr (SP2) {
        PG8_STAGE(PG8_SB(0, 0), cB, voffB); PG8_STAGE(PG8_SB(0, 1), cB + hstep, voffB); PG8_STAGE(PG8_SA(0, 0), cA, voffA); PG8_STAGE(PG8_SA(0, 1), cA + hstep, voffA);
        if (wr == 1) PG8_BAR;
        PG8_WAIT_V(2); PG8_BAR;
        PG8_STAGE(PG8_SB(1, 0), cB + kstep, voffB); PG8_STAGE(PG8_SA(1, 0), cA + kstep, voffA); PG8_STAGE(PG8_SB(1, 1), cB + hstep + kstep, voffB);
        PG8_WAIT_V(6); PG8_BAR;
    } else {
        PG8_STAGE(PG8_SB(0, 0), cB, voffB); PG8_STAGE(PG8_SA(0, 0), cA, voffA); PG8_STAGE(PG8_SB(0, 1), cB + hstep, voffB); PG8_STAGE(PG8_SA(0, 1), cA + hstep, voffA);
        if (wr == 1) PG8_BAR;
        PG8_WAIT_V(4); PG8_BAR;
        PG8_STAGE(PG8_SB(1, 0), cB + kstep, voffB); PG8_STAGE(PG8_SA(1, 0), cA + kstep, voffA); PG8_STAGE(PG8_SB(1, 1), cB + hstep + kstep, voffB);
        PG8_WAIT_V(6); PG8_BAR;
    }
    for (;;) {
        const bool has_next = S.next(ui + 1, nxt);
        const char* nA = has_next ? (const char*)g.A + (size_t)nxt.pm * tstep : cA; const char* nB = has_next ? (const char*)g.Bt + (size_t)nxt.pn * tstep : cB;
        for (int t = 0; t < nt; t += 2) {
            const bool last = (t == nt - 2);
            const char* a1 = cA + (size_t)(t + 1) * kstep;
            const char* a2 = last ? nA : cA + (size_t)(t + 2) * kstep; const char* b2 = last ? nB : cB + (size_t)(t + 2) * kstep;
            const char* a3 = a2 + kstep; const char* b3 = b2 + kstep;
            if (last && has_next) S.a_ready(nxt);
            if constexpr (SP2) {
            PG8_LDB(B0, 0, 0); PG8_LDB(B1, 0, 1); PG8_SCHED; PG8_LDA(At, 0, 0); PG8_STAGE(PG8_SA(1, 1), a1 + hstep, voffA);
            PG8_WAIT_V(8); PG8_WAIT_L(0); PG8_BAR; PG8_MMA(0, 0, At, B0); PG8_MMA(0, 1, At, B1); PG8_BAR; PG8_SCHED;
            PG8_LDA(At, 0, 1); PG8_STAGE(PG8_SB(0, 0), b2, voffB); PG8_STAGE(PG8_SB(0, 1), b2 + hstep, voffB); PG8_STAGE(PG8_SA(0, 0), a2, voffA);
            PG8_WAIT_V(8); PG8_WAIT_L(0); PG8_BAR; PG8_MMA(1, 0, At, B0); PG8_MMA(1, 1, At, B1); PG8_BAR; PG8_SCHED;
            PG8_LDB(B0, 1, 0); PG8_LDB(B1, 1, 1); PG8_SCHED; PG8_LDA(At, 1, 0); PG8_STAGE(PG8_SA(0, 1), a2 + hstep, voffA);
            PG8_WAIT_V(8); PG8_WAIT_L(0); PG8_BAR; PG8_MMA(0, 0, At, B0); PG8_MMA(0, 1, At, B1); PG8_BAR; PG8_SCHED;
            PG8_LDA(At, 1, 1); PG8_STAGE(PG8_SB(1, 0), b3, voffB); PG8_STAGE(PG8_SB(1, 1), b3 + hstep, voffB); PG8_STAGE(PG8_SA(1, 0), a3, voffA);
            PG8_WAIT_V(8); PG8_WAIT_L(0); PG8_BAR; PG8_MMA(1, 0, At, B0); PG8_MMA(1, 1, At, B1); PG8_BAR; PG8_SCHED;
            } else {
            PG8_LDB(B0, 0, 0); PG8_SCHED; PG8_LDA(At, 0, 0); PG8_STAGE(PG8_SA(1, 1), a1 + hstep, voffA);
            PG8_WAIT_L(8); PG8_BAR; PG8_WAIT_L(0); PG8_MMA(0, 0, At, B0); PG8_BAR; PG8_SCHED;
            PG8_LDB(B1, 0, 1); PG8_STAGE(PG8_SB(0, 0), b2, voffB);
            PG8_BAR; PG8_WAIT_L(0); PG8_MMA(0, 1, At, B1); PG8_BAR;
            PG8_LDA(At, 0, 1); PG8_STAGE(PG8_SA(0, 0), a2, voffA);
            PG8_BAR; PG8_WAIT_L(0); PG8_MMA(1, 0, At, B0); PG8_BAR; PG8_SCHED;
            PG8_STAGE(PG8_SB(0, 1), b2 + hstep, voffB);
            PG8_WAIT_V(6); PG8_BAR; PG8_MMA(1, 1, At, B1); PG8_BAR;
            PG8_LDB(B0, 1, 0); PG8_SCHED; PG8_LDA(At, 1, 0); PG8_STAGE(PG8_SA(0, 1), a2 + hstep, voffA);
            PG8_WAIT_L(8); PG8_BAR; PG8_WAIT_L(0); PG8_MMA(0, 0, At, B0); PG8_BAR; PG8_SCHED;
            PG8_LDB(B1, 1, 1); PG8_STAGE(PG8_SB(1, 0), b3, voffB);
            PG8_BAR; PG8_WAIT_L(0); PG8_MMA(0, 1, At, B1); PG8_BAR;
            PG8_LDA(At, 1, 1); PG8_STAGE(PG8_SA(1, 0), a3, voffA);
            PG8_BAR; PG8_WAIT_L(0); PG8_MMA(1, 0, At, B0); PG8_BAR; PG8_SCHED;
            PG8_STAGE(PG8_SB(1, 1), b3 + hstep, voffB);
            PG8_WAIT_V(6); PG8_BAR; PG8_MMA(1, 1, At, B1); PG8_BAR;
            }
        }
        if constexpr (ALIGN_EPI) { if (wr == 0) PG8_BAR; }
        if constexpr (!Epi::AFTER_DRAIN) { E(acc, cur, wr, wc, fr, fq); S.done(cur); }
        if (!has_next) break;
#pragma unroll
        for (int a = 0; a < 2; ++a)
#pragma unroll
            for (int b = 0; b < 2; ++b)
#pragma unroll
                for (int m = 0; m < 4; ++m)
#pragma unroll
                    for (int n = 0; n < 2; ++n) acc[a][b][m][n] = (f32x4){0.f, 0.f, 0.f, 0.f};
        cur = nxt; cA = nA; cB = nB; ++ui;
        if constexpr (ALIGN_EPI) { if (wr == 1) PG8_BAR; }
    }
    PG8_WAIT_V(0);
    if constexpr (!ALIGN_EPI) { if (wr == 0) PG8_BAR; }
    PG8_BAR;
    if constexpr (Epi::AFTER_DRAIN) { E.fused(acc, cur, wr, wc, fr, fq, lds, wid, lane); S.done(cur); }
#undef PG8_SA
#undef PG8_SB
#undef PG8_STAGE
#undef PG8_LDA
#undef PG8_LDB
#undef PG8_MMA
#undef PG8_WAIT_V
#undef PG8_WAIT_L
#undef PG8_BAR
#undef PG8_SCHED
}
}

#ifndef PG8_SP2
#define PG8_SP2 true
#endif
#ifndef PG8_ALIGN
#define PG8_ALIGN true
#endif
constexpr int NWAVES = 8;
constexpr int DM = 1024, TP = 8192, NBP = 8, MP = NBP * TP, NBS = 16, TS = 16, MS = NBS * TS, M = MP + MS;
constexpr int NCU = NBP * 128 + NBS;
constexpr int LDW_IN = 4112;
constexpr size_t O_Y = 0, O_CP = 67371008, O_GP = 67407872, O_KP = 67670016, O_VP = 69767168, O_CS = 71864320, O_GS = 71938048, O_KS = 72462336, O_VS = 72593408, O_END = 72724480;
constexpr size_t MiB = 1u << 20;
constexpr size_t WS_CTL = 0, CTL_ZERO_BYTES = 64 * 1024;
constexpr size_t WS_WIN = 1 * MiB, WS_WOUT = 9 * MiB, WS_WGATE = 11 * MiB, WS_WPLE = 13 * MiB;
constexpr size_t WS_WAB = 13 * MiB + 768 * 1024;
constexpr size_t WS_G = 14 * MiB, WS_BETA = 17 * MiB, WS_GT = 20 * MiB, WS_SSQ = 20 * MiB + 512 * 1024;
constexpr size_t WS_PB = 21 * MiB;
constexpr size_t WS_Z = 54 * MiB;
constexpr size_t WS_QKVA = 183 * MiB;
constexpr size_t WS_QKVB = 376 * MiB;
constexpr size_t WS_OPS = 569 * MiB;
constexpr size_t WS_QF = 894 * MiB;
constexpr size_t WS_KFS = 958 * MiB, WS_VFS = 968 * MiB, WS_QFS = 978 * MiB, WS_OAS = 979 * MiB, WS_END = 980 * MiB;
constexpr size_t WS_MIX = WS_QKVA, WS_H1B = WS_QKVB, WS_XN = WS_OPS, WS_E = WS_OPS;
constexpr size_t YO_KF = 0, YO_VF = 64 * MiB, YO_OA = 128 * MiB;
constexpr int CW_BAR = 4096, CW_ATT = 8192, CW_BP = 12288;
constexpr int OPS_UNIT = 40960, OPS_W = 0, OPS_KT = 8192, OPS_QD = 16384, OPS_QK = 24576, OPS_U = 32768;
constexpr int RING_BYTES = 131072, LDSCTL_OFF = RING_BYTES, MISC_OFF = LDSCTL_OFF + 320, LDS_BYTES = 163840;

#define GAS __attribute__((address_space(1)))
#define LAS __attribute__((address_space(3)))
typedef unsigned short bf16;
typedef unsigned v4u __attribute__((ext_vector_type(4)));
typedef unsigned v2u __attribute__((ext_vector_type(2)));
typedef float f32x4 __attribute__((ext_vector_type(4)));
typedef float f32x16 __attribute__((ext_vector_type(16)));
typedef short bf16x8 __attribute__((ext_vector_type(8)));
typedef GAS unsigned gu32;
#define RLX_AGENT __ATOMIC_RELAXED, __HIP_MEMORY_SCOPE_AGENT
#define LDS_WAIT() asm volatile("s_waitcnt lgkmcnt(0)" ::: "memory")
__device__ __forceinline__ unsigned pk2(float lo, float hi) { return pg8::cvt_pk_bf16_v(lo, hi); }
__device__ __forceinline__ float bflo(unsigned w) { return __uint_as_float(w << 16); }
__device__ __forceinline__ float bfhi(unsigned w) { return __uint_as_float(w & 0xffff0000u); }
__device__ __forceinline__ float bf1(unsigned short b) { return __uint_as_float((unsigned)b << 16); }
__device__ __forceinline__ float siluf(float x) { return x * __builtin_amdgcn_rcpf(1.0f + __expf(-x)); }
__device__ __forceinline__ void glds16_asm(const void* gsrc, LAS unsigned char* lds_dst, bool nt) {
    unsigned keep; const unsigned d = (unsigned)__builtin_amdgcn_readfirstlane((int)(unsigned)(uintptr_t)lds_dst);
    if (nt) asm volatile("s_mov_b32 %0, m0\n\ts_mov_b32 m0, %2\n\ts_nop 0\n\tglobal_load_lds_dwordx4 %1, off nt\n\ts_mov_b32 m0, %0" : "=&s"(keep) : "v"(gsrc), "s"(d) : "memory");
    else    asm volatile("s_mov_b32 %0, m0\n\ts_mov_b32 m0, %2\n\ts_nop 0\n\tglobal_load_lds_dwordx4 %1, off\n\ts_mov_b32 m0, %0" : "=&s"(keep) : "v"(gsrc), "s"(d) : "memory");
}
__device__ __forceinline__ float wave_sum(float v) {
#pragma unroll
    for (int o = 1; o < 64; o <<= 1) v += __shfl_xor(v, o);
    return v;
}
#define XB_TMO      128
#define XB_XCNT(j)  (256  + 64 * (j))
#define XB_XSUB(j)  (1280 + 64 * (j))
#define XB_XGEN(j)  (2304 + 64 * (j))
#define XB_TOP      3328
#define XB_TOPGEN   3392
#define XCD_BAR_WORDS 3456
#define XB_SPIN_CAP (1u << 18)

__device__ __forceinline__ unsigned xb_ld(unsigned* p)              { return __hip_atomic_load(p, __ATOMIC_RELAXED, __HIP_MEMORY_SCOPE_AGENT); }
__device__ __forceinline__ unsigned xb_add(unsigned* p, unsigned v) { return __hip_atomic_fetch_add(p, v, __ATOMIC_RELAXED, __HIP_MEMORY_SCOPE_AGENT); }
__device__ __forceinline__ unsigned xb_xcc_id() { return (unsigned)__builtin_amdgcn_s_getreg((3 << 11) | 20) & 0xFu; }
#define XB_SPIN(cond, bar) do { unsigned _sp = 0; while (cond) { __builtin_amdgcn_s_sleep(1); \
    if ((++_sp & 255u) == 0u) { if (xb_ld(&(bar)[XB_TMO])) break; if (_sp > XB_SPIN_CAP) { atomicAdd(&(bar)[XB_TMO], 1u); break; } } } } while (0)

struct XcdBarrier {
    unsigned* bar; unsigned x;
    volatile LAS unsigned* st;
};

__device__ __forceinline__ XcdBarrier xcd_barrier_post(unsigned* bar, volatile LAS unsigned* st) {
    XcdBarrier b; b.bar = bar; b.x = xb_xcc_id(); b.st = st;
    if (threadIdx.x == 0) (void)xb_add(&bar[XB_XCNT(b.x)], 1u);
    return b;
}
__device__ __forceinline__ void xcd_barrier_complete(unsigned* bar, unsigned x, unsigned& nloc, unsigned& nx) {
    const unsigned G = gridDim.x * gridDim.y * gridDim.z;
    unsigned sum, cnt, mine, sp = 0u;
    for (;;) {
        sum = 0u; cnt = 0u; mine = 0u;
#pragma unroll
        for (unsigned j = 0; j < 16; ++j) { const unsigned c = xb_ld(&bar[XB_XCNT(j)]); sum += c; cnt += (c > 0u) ? 1u : 0u; mine = (j == x) ? c : mine; }
        if (sum == G) break;
        __builtin_amdgcn_s_sleep(1);
        if ((++sp & 255u) == 0u) { if (xb_ld(&bar[XB_TMO])) break; if (sp > XB_SPIN_CAP) { atomicAdd(&bar[XB_TMO], 1u); break; } }
    }
    nloc = mine > 0u ? mine : 1u; nx = cnt > 0u ? cnt : 1u;
}

__device__ __forceinline__ void xcd_barrier(const XcdBarrier& b) {
    asm volatile("s_waitcnt vmcnt(0)" ::: "memory");
    __syncthreads();
    if (threadIdx.x == 0) {
        unsigned* bar = b.bar;
        __builtin_amdgcn_s_waitcnt(0);
        unsigned nloc = b.st[0], nx = b.st[1];
        if (nloc == 0u) { xcd_barrier_complete(bar, b.x, nloc, nx); b.st[0] = nloc; b.st[1] = nx; }
        const unsigned old = xb_add(&bar[XB_XSUB(b.x)], 1u);
        const unsigned gen = old / nloc;
        if (old + 1u == (gen + 1u) * nloc) {
            __builtin_amdgcn_fence(__ATOMIC_RELEASE, "agent");
            asm volatile("s_waitcnt vmcnt(0)" ::: "memory");
            const unsigned og = xb_add(&bar[XB_TOP], 1u);
            const unsigned tg = og / nx;
            if (og + 1u == (tg + 1u) * nx) xb_add(&bar[XB_TOPGEN], 1u);
            else XB_SPIN(xb_ld(&bar[XB_TOPGEN]) == tg, bar);
            __builtin_amdgcn_fence(__ATOMIC_ACQUIRE, "agent");
            xb_add(&bar[XB_XGEN(b.x)], 1u);
            asm volatile("s_waitcnt vmcnt(0)" ::: "memory");
        } else {
            XB_SPIN(xb_ld(&bar[XB_XGEN(b.x)]) == gen, bar);
            __builtin_amdgcn_fence(__ATOMIC_ACQUIRE, "agent");
            asm volatile("s_waitcnt vmcnt(0)" ::: "memory");
        }
    }
    __syncthreads();
}

struct Params {
    const float* x_p; const float* x_s; const float* state_conv; const float* state_gdn; const float* cache_k; const float* cache_v;
    const float* p_p; const float* p_s; const float* ln_g; const float* w_in; const float* conv_w; const float* a_log; const float* dt_bias;
    const float* gdn_g; const float* qn_g; const float* kn_g; const float* rel_bias; const float* w_out; const float* w_ple; const float* ple_g; const float* w_gate;
    float* out; unsigned char* ws; int ph_lo, ph_hi, flags, pad;
};
__device__ __forceinline__ f32x4 mfma16(bf16x8 a, bf16x8 b, f32x4 c) { return __builtin_amdgcn_mfma_f32_16x16x32_bf16(a, b, c, 0, 0, 0); }
__device__ __forceinline__ f32x16 mfma32(bf16x8 a, bf16x8 b, f32x16 c) { return __builtin_amdgcn_mfma_f32_32x32x16_bf16(a, b, c, 0, 0, 0); }
__device__ __forceinline__ bf16x8 pack8(f32x4 a, f32x4 b) { v4u w; w.x = pk2(a[0], a[1]); w.y = pk2(a[2], a[3]); w.z = pk2(b[0], b[1]); w.w = pk2(b[2], b[3]); return __builtin_bit_cast(bf16x8, w); }
__device__ __forceinline__ void unpack8(v4u w, float (&f)[8]) { f[0] = bflo(w.x); f[1] = bfhi(w.x); f[2] = bflo(w.y); f[3] = bfhi(w.y); f[4] = bflo(w.z); f[5] = bfhi(w.z); f[6] = bflo(w.w); f[7] = bfhi(w.w); }
__device__ __forceinline__ v4u packf8(const float (&f)[8]) { v4u w; w.x = pk2(f[0], f[1]); w.y = pk2(f[2], f[3]); w.z = pk2(f[4], f[5]); w.w = pk2(f[6], f[7]); return w; }

__device__ __forceinline__ void p0_tile(const float* W, int ldw, int srccol0, bf16* WT, int K, int dstrow0, int k0, LAS float* scr, int lane) {
#pragma unroll 8
    for (int i = 0; i < 32; ++i) { const int kk = 2 * i + (lane >> 5); scr[kk * 33 + (lane & 31)] = W[(size_t)(k0 + kk) * ldw + srccol0 + (lane & 31)]; }
    LDS_WAIT(); asm volatile("" ::: "memory");
    const int c = lane & 7;
#pragma unroll
    for (int j = 0; j < 4; ++j) { const int n = (lane >> 3) + 8 * j; const LAS float* s = scr + (8 * c) * 33 + n;
        v4u o; o.x = pk2(s[0 * 33], s[1 * 33]); o.y = pk2(s[2 * 33], s[3 * 33]); o.z = pk2(s[4 * 33], s[5 * 33]); o.w = pk2(s[6 * 33], s[7 * 33]);
        *(v4u*)(WT + (size_t)(dstrow0 + n) * K + k0 + 8 * c) = o; }
    LDS_WAIT(); asm volatile("" ::: "memory");
}
__device__ __forceinline__ void phase0(const Params& P, LAS unsigned char* lds, int tid, int lane, int wave, int G) {
    unsigned char* ws = P.ws;
    const int gw = blockIdx.x * NWAVES + wave, NGW = G * NWAVES;
    LAS float* scr = (LAS float*)(lds + wave * 16384);
    bf16* WIN = (bf16*)(ws + WS_WIN); bf16* WOUT = (bf16*)(ws + WS_WOUT); bf16* WGATE = (bf16*)(ws + WS_WGATE); bf16* WPLE = (bf16*)(ws + WS_WPLE);
    constexpr int I_IN = 128 * 16, I_SQ = 32 * 16, I_PLE = 32 * 4, NITEMS = I_IN + 2 * I_SQ + I_PLE;
    for (int it = gw; it < NITEMS; it += NGW) {
        int r = it;
        if (r < I_IN) { const int n0 = 32 * (r & 127), kb = r >> 7; const int src = n0 < 1536 ? n0 : (n0 < 3072 ? n0 + 528 : (n0 < 3584 ? n0 - 1520 : n0 + 16));
            p0_tile(P.w_in, LDW_IN, src, WIN, 1024, n0, 64 * kb, scr, lane); continue; }
        r -= I_IN;
        if (r < I_SQ) { p0_tile(P.w_out, 1024, 32 * (r & 31), WOUT, 1024, 32 * (r & 31), 64 * (r >> 5), scr, lane); continue; }
        r -= I_SQ;
        if (r < I_SQ) { p0_tile(P.w_gate, 1024, 32 * (r & 31), WGATE, 1024, 32 * (r & 31), 64 * (r >> 5), scr, lane); continue; }
        r -= I_SQ;
        p0_tile(P.w_ple, 1024, 32 * (r & 31), WPLE, 256, 32 * (r & 31), 64 * (r >> 5), scr, lane);
    }
    {
        bf16* WAB = (bf16*)(ws + WS_WAB);
        for (int idx = blockIdx.x * 512 + tid; idx < 16384; idx += G * 512) { const int k = idx >> 4, c = idx & 15; WAB[c * 1024 + k] = (bf16)(pk2(P.w_in[(size_t)k * LDW_IN + 1536 + c], 0.f) & 0xffffu); }
    }
    f32x4 lg[4];
#pragma unroll
    for (int j = 0; j < 4; ++j) lg[j] = ((const f32x4*)P.ln_g)[64 * j + lane];
    bf16* XN = (bf16*)(ws + WS_XN);
    f32x4 vnx[4];
    if (gw < M) { const float* xr0 = gw < MP ? P.x_p + (size_t)gw * 1024 : P.x_s + (size_t)(gw - MP) * 1024;
#pragma unroll
        for (int j = 0; j < 4; ++j) vnx[j] = ((const f32x4*)xr0)[64 * j + lane]; }
    for (int m = gw; m < M; m += NGW) {
        f32x4 v[4]; float ss = 0.f;
#pragma unroll
        for (int j = 0; j < 4; ++j) { v[j] = vnx[j]; ss += (v[j][0] * v[j][0] + v[j][1] * v[j][1]) + (v[j][2] * v[j][2] + v[j][3] * v[j][3]); }
        { const int mn = m + NGW; if (mn < M) { const float* xrn = mn < MP ? P.x_p + (size_t)mn * 1024 : P.x_s + (size_t)(mn - MP) * 1024;
#pragma unroll
            for (int j = 0; j < 4; ++j) vnx[j] = ((const f32x4*)xrn)[64 * j + lane]; } }
        ss = wave_sum(ss);
        const float rstd = 1.0f / sqrtf(ss * (1.0f / 1024.0f) + 1e-6f);
        v2u* o8 = (v2u*)(XN + (size_t)m * 1024) + lane;
#pragma unroll
        for (int j = 0; j < 4; ++j) { v[j] = v[j] * rstd * lg[j]; v2u o; o.x = pk2(v[j][0], v[j][1]); o.y = pk2(v[j][2], v[j][3]); o8[64 * j] = o; }
    }
    bf16* PB = (bf16*)(ws + WS_PB);
    for (int m0 = gw; m0 < M; m0 += 4 * NGW) {
        f32x4 pv[4];
#pragma unroll
        for (int k = 0; k < 4; ++k) { const int m = m0 + k * NGW; if (m < M) { const float* prow = m < MP ? P.p_p + (size_t)m * 256 : P.p_s + (size_t)(m - MP) * 256; pv[k] = ((const f32x4*)prow)[lane]; } }
#pragma unroll
        for (int k = 0; k < 4; ++k) { const int m = m0 + k * NGW; if (m < M) { v2u o; o.x = pk2(pv[k][0], pv[k][1]); o.y = pk2(pv[k][2], pv[k][3]); ((v2u*)(PB + (size_t)m * 256))[lane] = o; } }
    }
    float* ssq = (float*)(ws + WS_SSQ);
    for (int i = blockIdx.x * 512 + tid; i < M; i += G * 512) ssq[i] = 0.f;
}
constexpr int QB_OFF = 0, KB_OFF = 9216, VB_OFF = 18432, XQK_OFF = 27648, XW_OFF = 27648, RAW_OFF = 27648  , LM_OFF = 36864, SC_OFF = 54272, DI_OFF = 55552, CW_OFF = 59648, HEAD_LDS = 62720;
struct GdnItem { int cu, s, c, L, m0; bool smp; };
__device__ __forceinline__ GdnItem gdn_item(int item) { GdnItem I; I.cu = item >> 2; I.smp = I.cu >= 1024; I.s = I.smp ? I.cu - 1024 : I.cu >> 7; I.c = I.smp ? 0 : I.cu & 127; I.L = I.smp ? 16 : 64; I.m0 = I.smp ? MP + I.s * 16 : I.s * TP + I.c * 64; return I; }
__device__ __forceinline__ void split4(f32x4 x, f32x4& hi, f32x4& lo) {
#pragma unroll
    for (int i = 0; i < 4; ++i) { const float h = __uint_as_float(pk2(x[i], 0.f) << 16); hi[i] = h; lo[i] = x[i] - h; }
}
__device__ __forceinline__ void gdn_prep_all(const Params& P, LAS unsigned char* lds, int tid, int lane, int wave, int G) {
    const int hh = wave >> 2, tih = tid & 255, wq = wave & 3;
    LAS unsigned char* hb = lds + hh * HEAD_LDS;
    LAS float* sc = (LAS float*)(hb + SC_OFF);
    const float* Gd = (const float*)(P.ws + WS_G); const float* Bd = (const float*)(P.ws + WS_BETA); float* GT = (float*)(P.ws + WS_GT);
    const bf16* QKVA = (const bf16*)(P.ws + WS_QKVA);
    const int t1 = tih >> 2, cg = tih & 3;
    v4u pre[7]; float gpre = 0.f, bpre = 0.f;
    int cw_hp = -1;
    const f32x4 z4 = {0.f, 0.f, 0.f, 0.f};
#define GDN_PREFETCH(itemv) do { const GdnItem J = gdn_item(itemv); const int hJ = 2 * ((itemv) & 3) + hh; \
        _Pragma("unroll") for (int k = 0; k < 7; ++k) { const int q = tih + 256 * k, rr = q / 24, pc = q - rr * 24, r = rr - 3, col = (pc >> 3) * 512 + hJ * 64 + (pc & 7) * 8; \
            v4u w = {0u, 0u, 0u, 0u}; \
            if (q < 1608 && r < J.L) { \
                if (r >= 0 || (!J.smp && J.c > 0)) w = *(const v4u*)(QKVA + (size_t)((long)J.m0 + r) * 1536 + col); \
                else if (J.smp) { const float* sp = P.state_conv + ((size_t)J.s * 3 + rr) * 1536 + col; const f32x4 a = ((const f32x4*)sp)[0], b = ((const f32x4*)sp)[1]; \
                    w.x = pk2(a[0], a[1]); w.y = pk2(a[2], a[3]); w.z = pk2(b[0], b[1]); w.w = pk2(b[2], b[3]); } } \
            pre[k] = w; } \
        if (wq == 0) { gpre = 0.f; bpre = 0.f; if (lane < J.L) { gpre = Gd[(size_t)(J.m0 + lane) * 8 + hJ]; bpre = Bd[(size_t)(J.m0 + lane) * 8 + hJ]; } } } while (0)
    if ((int)blockIdx.x < NCU * 4) GDN_PREFETCH((int)blockIdx.x);
#pragma unroll 1
    for (int item = blockIdx.x; item < NCU * 4; item += G) {
        const GdnItem I = gdn_item(item); const int hp = item & 3, h = 2 * hp + hh;
        if (hp != cw_hp) {
            __syncthreads();
            for (int idx = tih; idx < 768; idx += 256) { const int j = idx / 192, cc = idx % 192; ((LAS float*)(hb + CW_OFF))[idx] = P.conv_w[j * 1536 + (cc >> 6) * 512 + h * 64 + (cc & 63)]; }
            cw_hp = hp;
            __syncthreads();
        }
#pragma unroll
        for (int k = 0; k < 7; ++k) { const int q = tih + 256 * k; if (q < 1608) *(LAS v4u*)(hb + RAW_OFF + q * 16) = pre[k]; }
        __syncthreads();
        if (wq == 0) {
            const int t = lane; float v = gpre;
#pragma unroll
            for (int off = 1; off < 64; off <<= 1) { const float o = __shfl_up(v, off); if (lane >= off) v += o; }
            const float glast = __shfl(v, 63);
            const float eg = expf(v);
            sc[t] = v; sc[64 + t] = bpre; sc[128 + t] = eg; sc[192 + t] = expf(glast - v); sc[256 + t] = bpre * eg;
            if (t == 0) GT[I.cu * 8 + h] = expf(glast);
        }
#ifdef PROBE_PREFIX
        if (!(P.flags & 256))
#endif
        {
            const int t = t1;
#pragma unroll
            for (int p = 0; p < 3; ++p) {
                float acc[16];
#pragma unroll
                for (int i = 0; i < 16; ++i) acc[i] = 0.f;
#pragma unroll
                for (int j = 0; j < 4; ++j) {
                    float rw[16];
                    { const LAS v4u* rp = (const LAS v4u*)(hb + RAW_OFF + (t + j) * 384 + (p * 64 + 16 * cg) * 2);
                      float f0[8], f1[8]; unpack8(rp[0], f0); unpack8(rp[1], f1);
#pragma unroll
                      for (int i = 0; i < 8; ++i) { rw[i] = f0[i]; rw[8 + i] = f1[i]; } }
                    const LAS float* cwj = (const LAS float*)(hb + CW_OFF) + j * 192 + p * 64 + 16 * cg;
#pragma unroll
                    for (int i4 = 0; i4 < 4; ++i4) { const f32x4 w = ((const LAS f32x4*)cwj)[i4];
                        acc[4 * i4] += rw[4 * i4] * w[0]; acc[4 * i4 + 1] += rw[4 * i4 + 1] * w[1]; acc[4 * i4 + 2] += rw[4 * i4 + 2] * w[2]; acc[4 * i4 + 3] += rw[4 * i4 + 3] * w[3]; }
                }
                float ss = 0.f;
#pragma unroll
                for (int i = 0; i < 16; ++i) { acc[i] = siluf(acc[i]); ss += acc[i] * acc[i]; }
                ss += __shfl_xor(ss, 1); ss += __shfl_xor(ss, 2);
                float scale = 1.f;
                if (p == 0) scale = 0.125f * __builtin_amdgcn_rsqf(ss + 1e-6f); else if (p == 1) scale = __builtin_amdgcn_rsqf(ss + 1e-6f);
                if (t >= I.L) scale = 0.f;
                v4u o0, o1;
                o0.x = pk2(acc[0] * scale, acc[1] * scale); o0.y = pk2(acc[2] * scale, acc[3] * scale); o0.z = pk2(acc[4] * scale, acc[5] * scale); o0.w = pk2(acc[6] * scale, acc[7] * scale);
                o1.x = pk2(acc[8] * scale, acc[9] * scale); o1.y = pk2(acc[10] * scale, acc[11] * scale); o1.z = pk2(acc[12] * scale, acc[13] * scale); o1.w = pk2(acc[14] * scale, acc[15] * scale);
                LAS v4u* dst = (LAS v4u*)(hb + p * 9216 + t * 144 + cg * 32);
                dst[0] = o0; dst[1] = o1;
            }
        }
        if (item + G < NCU * 4) GDN_PREFETCH(item + G);
        __syncthreads();
#ifdef PROBE_PREFIX
        if (!(P.flags & 512))
#endif
        {
            const int i = lane & 15, q4 = lane >> 4;
            const LAS unsigned char* kbp = hb + KB_OFF; const LAS unsigned char* qbp = hb + QB_OFF;
#pragma unroll
            for (int k3 = 0; k3 < 3; ++k3) {
                const int idx = wq + 4 * k3;
                if (idx < 10) {
                    const int rho = (idx >= 6) ? 3 : ((idx >= 3) ? 2 : ((idx >= 1) ? 1 : 0)), rp = idx - (rho * (rho + 1)) / 2;
                    bf16x8 ka[2], qa[2], kf[2];
#pragma unroll
                    for (int s2 = 0; s2 < 2; ++s2) { ka[s2] = *(const LAS bf16x8*)(kbp + (16 * rho + i) * 144 + 64 * s2 + 16 * q4); qa[s2] = *(const LAS bf16x8*)(qbp + (16 * rho + i) * 144 + 64 * s2 + 16 * q4);
                        kf[s2] = *(const LAS bf16x8*)(kbp + (16 * rp + i) * 144 + 64 * s2 + 16 * q4); }
                    f32x4 akk = z4, aqk = z4;
#pragma unroll
                    for (int s2 = 0; s2 < 2; ++s2) { akk = mfma16(ka[s2], kf[s2], akk); aqk = mfma16(qa[s2], kf[s2], aqk); }
                    const int tc = 16 * rp + i; const float gcol = sc[tc];
#pragma unroll
                    for (int r = 0; r < 4; ++r) { const int t = 16 * rho + 4 * q4 + r; const float dec = __expf(fminf(sc[t] - gcol, 0.f));
                        const float lv = (tc < t) ? sc[64 + t] * akk[r] * dec : 0.f; const float qv = (tc <= t) ? aqk[r] * dec : 0.f;
                        *(LAS float*)(hb + LM_OFF + t * 272 + tc * 4) = lv;
                        *(LAS unsigned short*)(hb + XQK_OFF + t * 144 + tc * 2) = (unsigned short)(pk2(qv, 0.f) & 0xffffu); }
                }
            }
#pragma unroll
            for (int rp = 1; rp < 4; ++rp) if (rp > wq) {
                const int tc = 16 * rp + i;
#pragma unroll
                for (int r = 0; r < 4; ++r) { const int t = 16 * wq + 4 * q4 + r; *(LAS unsigned short*)(hb + XQK_OFF + t * 144 + tc * 2) = 0; }
            }
        }
        __syncthreads();
        unsigned char* ops = P.ws + WS_OPS + ((size_t)I.cu * 8 + h) * OPS_UNIT;
#ifdef PROBE_PREFIX
        if (!(P.flags & 1024))
#endif
        if (wq == 0) {
            const int b = lane >> 4, c = lane & 15;
            float d[16];
#pragma unroll
            for (int i = 0; i < 16; ++i) {
                float a0 = (i == c) ? 1.f : 0.f;
#pragma unroll
                for (int k = 0; k < (i + 3) / 4; ++k) { const f32x4 l4 = *(const LAS f32x4*)(hb + LM_OFF + (16 * b + i) * 272 + (16 * b + 4 * k) * 4);
#pragma unroll
                    for (int e = 0; e < 4; ++e) if (4 * k + e < i) a0 -= l4[e] * d[4 * k + e]; }
                d[i] = a0;
            }
#pragma unroll
            for (int i = 0; i < 16; ++i) *(LAS float*)(hb + DI_OFF + ((b * 16 + i) * 16 + c) * 4) = d[i];
        } else {
            const int i = lane & 15, q4 = lane >> 4, kind = wq - 1;
#pragma unroll 1
            for (int fr = 0; fr < 8; ++fr) {
                const int rho = fr >> 1, s2 = fr & 1, row = 16 * rho + i;
                v4u o; unsigned char* dst; int frp = fr;
                if (kind == 0) { const v2u lo = *(const LAS v2u*)(hb + XQK_OFF + row * 144 + (32 * s2 + 4 * q4) * 2), hi = *(const LAS v2u*)(hb + XQK_OFF + row * 144 + (32 * s2 + 16 + 4 * q4) * 2);
                    o.x = lo.x; o.y = lo.y; o.z = hi.x; o.w = hi.y; dst = ops + OPS_QK;
                    frp = (fr == 0) ? 0 : (fr == 2) ? 1 : (fr >= 4) ? fr - 2 : (fr == 1 ? 6 : 7); }
                else if (kind == 1) { const v2u lo = *(const LAS v2u*)(hb + QB_OFF + row * 144 + (32 * s2 + 4 * q4) * 2), hi = *(const LAS v2u*)(hb + QB_OFF + row * 144 + (32 * s2 + 16 + 4 * q4) * 2);
                    const float e = sc[128 + row];
                    o.x = pk2(bflo(lo.x) * e, bfhi(lo.x) * e); o.y = pk2(bflo(lo.y) * e, bfhi(lo.y) * e); o.z = pk2(bflo(hi.x) * e, bfhi(hi.x) * e); o.w = pk2(bflo(hi.y) * e, bfhi(hi.y) * e); dst = ops + OPS_QD; }
                else { float vv[8];
#pragma unroll
                    for (int e = 0; e < 8; ++e) { const int t = 32 * s2 + 16 * (e >> 2) + 4 * q4 + (e & 3); vv[e] = bf1(*(const LAS unsigned short*)(hb + KB_OFF + t * 144 + (16 * rho + i) * 2)) * sc[192 + t]; }
                    o = packf8(vv); dst = ops + OPS_KT; }
                *(v4u*)(dst + (frp * 64 + lane) * 16) = o;
            }
        }
        __syncthreads();
#ifdef PROBE_PREFIX
        if (!(P.flags & 2048))
#endif
        {
            const int l15 = lane & 15, q4 = lane >> 4;
            const LAS unsigned char* src = hb + (wq < 2 ? VB_OFF : KB_OFF); const LAS float* scl = sc + (wq < 2 ? 64 : 256);
            f32x4 X[4][2];
#pragma unroll
            for (int b = 0; b < 4; ++b) {
                f32x4 acc[2];
#pragma unroll
                for (int ct = 0; ct < 2; ++ct) { const int col = 32 * (wq & 1) + 16 * ct + l15;
#pragma unroll
                    for (int r = 0; r < 4; ++r) { const int t = 16 * b + 4 * q4 + r; acc[ct][r] = bf1(*(const LAS unsigned short*)(src + t * 144 + col * 2)) * scl[t]; } }
#pragma unroll
                for (int pr = 0; pr < 2; ++pr) {
                    const int m0 = 2 * pr, m1 = 2 * pr + 1;
                    if (m0 < b) {
                        f32x4 l0 = *(const LAS f32x4*)(hb + LM_OFF + (16 * b + l15) * 272 + (16 * m0 + 4 * q4) * 4), l1 = z4;
                        if (m1 < b) l1 = *(const LAS f32x4*)(hb + LM_OFF + (16 * b + l15) * 272 + (16 * m1 + 4 * q4) * 4);
                        const bf16x8 An = pack8(-l0, -l1);
#pragma unroll
                        for (int ct = 0; ct < 2; ++ct) acc[ct] = mfma16(An, pack8(X[m0][ct], (m1 < b) ? X[m1][ct] : z4), acc[ct]);
                    }
                }
                const f32x4 dv = *(const LAS f32x4*)(hb + DI_OFF + ((b * 16 + l15) * 16 + 4 * q4) * 4);
                const bf16x8 Dn = pack8(dv, z4);
#pragma unroll
                for (int ct = 0; ct < 2; ++ct) X[b][ct] = mfma16(Dn, pack8(acc[ct], z4), z4);
            }
            if (wq < 2) {
#pragma unroll
                for (int b = 0; b < 4; ++b)
#pragma unroll
                    for (int ct = 0; ct < 2; ++ct) { const int slice = 2 * (wq & 1) + ct; v2u o; o.x = pk2(X[b][ct][0], X[b][ct][1]); o.y = pk2(X[b][ct][2], X[b][ct][3]);
                        *(v2u*)(ops + OPS_U + ((slice * 4 + b) * 64 + lane) * 8) = o; }
            } else {
#pragma unroll
                for (int b = 0; b < 4; ++b)
#pragma unroll
                    for (int ct = 0; ct < 2; ++ct) { const int col = 32 * (wq & 1) + 16 * ct + l15;
#pragma unroll
                        for (int r = 0; r < 4; ++r) *(LAS unsigned short*)(hb + XW_OFF + (16 * b + 4 * q4 + r) * 144 + col * 2) = (unsigned short)(pk2(X[b][ct][r], 0.f) & 0xffffu); }
            }
        }
        __syncthreads();
        {
            const int i = lane & 15, q4 = lane >> 4;
#pragma unroll
            for (int ff = 0; ff < 2; ++ff) { const int fr = wq * 2 + ff, rho = fr >> 1, s2 = fr & 1, row = 16 * rho + i;
                const v2u lo = *(const LAS v2u*)(hb + XW_OFF + row * 144 + (32 * s2 + 4 * q4) * 2), hi = *(const LAS v2u*)(hb + XW_OFF + row * 144 + (32 * s2 + 16 + 4 * q4) * 2);
                v4u o; o.x = lo.x; o.y = lo.y; o.z = hi.x; o.w = hi.y;
                *(v4u*)(ops + OPS_W + (fr * 64 + lane) * 16) = o; }
        }
        __syncthreads();
    }
#undef GDN_PREFETCH
}
__device__ __forceinline__ void bprep_item(const Params& P, LAS unsigned char* lds, int item, int tid, int lane, int wave) {
    int mode, s, c = 0, pi = 0;
    if (item < 1024) { mode = 0; s = item >> 7; c = item & 127; } else if (item < NCU) { mode = 1; s = item - 1024; } else { mode = 2; s = (item - NCU) >> 3; pi = (item - NCU) & 7; }
    const int tl = tid >> 3, part = tid & 7, kk = part >> 1, hh2 = part & 1, l31 = tl & 31;
    const bf16* QKVB = (const bf16*)(P.ws + WS_QKVB);
    unsigned char* yscr = (unsigned char*)P.out;
    const bool valid = (mode == 1) ? (tl < 16) : true;
    const long m = (mode == 0) ? (long)s * TP + c * 64 + tl : (long)MP + s * 16 + tl;
    size_t kvblk, qblk = 0; unsigned char *kdst, *vdst, *qdst = nullptr;
    if (mode == 0) { kvblk = (size_t)(m >> 5); qblk = kvblk; kdst = yscr + YO_KF; vdst = yscr + YO_VF; qdst = P.ws + WS_QF; }
    else if (mode == 1) { kvblk = (size_t)s * 18 + 16 + (tl >> 5); qblk = (size_t)s * 2 + (tl >> 5); kdst = P.ws + WS_KFS; vdst = P.ws + WS_VFS; qdst = P.ws + WS_QFS; }
    else { kvblk = (size_t)s * 18 + 2 * pi + (tl >> 5); kdst = P.ws + WS_KFS; vdst = P.ws + WS_VFS; }
    const size_t piece = (size_t)kk * 1024 + (size_t)(hh2 * 32 + l31) * 16;
    float qg[8], kg[8];
#pragma unroll
    for (int i = 0; i < 8; ++i) { qg[i] = P.qn_g[8 * part + i]; kg[i] = P.kn_g[8 * part + i]; }
#pragma unroll 1
    for (int hb4 = 0; hb4 < 8; hb4 += 4) {
        v4u wq_[4], wk_[4], wv_[4]; f32x4 ck_[4][2], cv_[4][2];
#pragma unroll
        for (int hi = 0; hi < 4; ++hi) { const int h = hb4 + hi;
            if (mode != 2) { wq_[hi] = wk_[hi] = wv_[hi] = (v4u){0u, 0u, 0u, 0u};
                if (valid) { const bf16* rp = QKVB + (size_t)m * 1536 + h * 64 + 8 * part; wq_[hi] = *(const v4u*)rp; wk_[hi] = *(const v4u*)(rp + 512); wv_[hi] = *(const v4u*)(rp + 1024); } }
            else { const size_t co = (((size_t)s * 512 + 64 * pi + tl) * 8 + h) * 64 + 8 * part;
                ck_[hi][0] = ((const f32x4*)(P.cache_k + co))[0]; ck_[hi][1] = ((const f32x4*)(P.cache_k + co))[1]; cv_[hi][0] = ((const f32x4*)(P.cache_v + co))[0]; cv_[hi][1] = ((const f32x4*)(P.cache_v + co))[1]; } }
#pragma unroll
        for (int hi = 0; hi < 4; ++hi) { const int h = hb4 + hi;
            float f[8];
            if (mode != 2) {
                unpack8(wq_[hi], f); float ss = 0.f;
#pragma unroll
                for (int i = 0; i < 8; ++i) ss += f[i] * f[i];
                ss += __shfl_xor(ss, 1); ss += __shfl_xor(ss, 2); ss += __shfl_xor(ss, 4);
                float rstd = __builtin_amdgcn_rsqf(ss * (1.0f / 64.0f) + 1e-6f);
#pragma unroll
                for (int i = 0; i < 8; ++i) f[i] = f[i] * (rstd * 0.18033688011f) * qg[i];
                *(v4u*)(qdst + (qblk * 8 + h) * 4096 + piece) = packf8(f);
                unpack8(wk_[hi], f); ss = 0.f;
#pragma unroll
                for (int i = 0; i < 8; ++i) ss += f[i] * f[i];
                ss += __shfl_xor(ss, 1); ss += __shfl_xor(ss, 2); ss += __shfl_xor(ss, 4);
                rstd = __builtin_amdgcn_rsqf(ss * (1.0f / 64.0f) + 1e-6f);
#pragma unroll
                for (int i = 0; i < 8; ++i) f[i] = f[i] * rstd * kg[i];
            } else { f[0] = ck_[hi][0][0]; f[1] = ck_[hi][0][1]; f[2] = ck_[hi][0][2]; f[3] = ck_[hi][0][3]; f[4] = ck_[hi][1][0]; f[5] = ck_[hi][1][1]; f[6] = ck_[hi][1][2]; f[7] = ck_[hi][1][3]; }
            *(v4u*)(kdst + (kvblk * 8 + h) * 4096 + piece) = packf8(f);
            {
                float* ko = nullptr;
                if (mode == 0) { const int ts = c * 64 + tl; if (ts >= TP - 512) ko = P.out + O_KP + (((size_t)s * 512 + (ts - (TP - 512))) * 8 + h) * 64 + 8 * part; }
                else if (mode == 1 && valid) ko = P.out + O_KS + (((size_t)s * 16 + tl) * 8 + h) * 64 + 8 * part;
                if (ko) { ((f32x4*)ko)[0] = (f32x4){f[0], f[1], f[2], f[3]}; ((f32x4*)ko)[1] = (f32x4){f[4], f[5], f[6], f[7]}; }
            }
            if (mode != 2) unpack8(wv_[hi], f);
            else { f[0] = cv_[hi][0][0]; f[1] = cv_[hi][0][1]; f[2] = cv_[hi][0][2]; f[3] = cv_[hi][0][3]; f[4] = cv_[hi][1][0]; f[5] = cv_[hi][1][1]; f[6] = cv_[hi][1][2]; f[7] = cv_[hi][1][3]; }
            {
                float* vo = nullptr;
                if (mode == 0) { const int ts = c * 64 + tl; if (ts >= TP - 512) vo = P.out + O_VP + (((size_t)s * 512 + (ts - (TP - 512))) * 8 + h) * 64 + 8 * part; }
                else if (mode == 1 && valid) vo = P.out + O_VS + (((size_t)s * 16 + tl) * 8 + h) * 64 + 8 * part;
                if (vo) { ((f32x4*)vo)[0] = (f32x4){f[0], f[1], f[2], f[3]}; ((f32x4*)vo)[1] = (f32x4){f[4], f[5], f[6], f[7]}; }
            }
            *(LAS v4u*)(lds + (h * 64 + tl) * 144 + part * 16) = packf8(f);
        }
    }
    __syncthreads();
    {
        const size_t blk0 = (mode == 0) ? (size_t)((s * TP + c * 64) >> 5) : (mode == 1 ? (size_t)s * 18 + 16 : (size_t)s * 18 + 2 * pi);
        const int l31v = lane & 31, hhv = lane >> 5;
#pragma unroll 1
        for (int it = 0; it < 8; ++it) {
            const int frag = it * 8 + wave, s2 = frag & 1, dt = (frag >> 1) & 1, h = (frag >> 2) & 7, blkl = frag >> 5;
            float vv[8];
#pragma unroll
            for (int e = 0; e < 8; ++e) { const int key = 32 * blkl + 16 * s2 + 8 * (e >> 2) + 4 * hhv + (e & 3);
                vv[e] = bf1(*(const LAS unsigned short*)(lds + (h * 64 + key) * 144 + (32 * dt + l31v) * 2)); }
            *(v4u*)(vdst + ((blk0 + blkl) * 8 + h) * 4096 + (size_t)(dt * 2 + s2) * 1024 + lane * 16) = packf8(vv);
        }
    }
    __syncthreads();
}
__device__ __forceinline__ void conv_state_out(const Params& P, int tid, int G) {
    const bf16* QKVA = (const bf16*)(P.ws + WS_QKVA);
    for (int idx = blockIdx.x * 512 + tid; idx < 24 * 3 * 1536; idx += G * 512) {
        const int col = idx % 1536, j = (idx / 1536) % 3, sq = idx / (3 * 1536);
        if (sq < 8) P.out[O_CP + ((size_t)sq * 3 + j) * 1536 + col] = bf1(QKVA[((size_t)sq * TP + TP - 3 + j) * 1536 + col]);
        else { const int s = sq - 8; P.out[O_CS + ((size_t)s * 3 + j) * 1536 + col] = bf1(QKVA[((size_t)MP + s * 16 + 13 + j) * 1536 + col]); }
    }
}
__device__ __forceinline__ void scan_chain(const Params& P, bool smp, int s, int h, int sl, int lane) {
    const int l15 = lane & 15, q4 = lane >> 4, e = 16 * sl + l15;
    const int cu0 = smp ? 1024 + s : s * 128, nsteps = smp ? 1 : 128;
    f32x4 S[4];
#pragma unroll
    for (int tau = 0; tau < 4; ++tau)
#pragma unroll
        for (int r = 0; r < 4; ++r) S[tau][r] = smp ? P.state_gdn[(((size_t)s * 8 + h) * 64 + 16 * tau + 4 * q4 + r) * 64 + e] : 0.f;
    const float* GT = (const float*)(P.ws + WS_GT);
    float* OA = (float*)((unsigned char*)P.out + YO_OA); float* OAS = (float*)(P.ws + WS_OAS);
#pragma unroll 1
    for (int n = 0; n < nsteps; ++n) {
        const int cu = cu0 + n; const unsigned char* ops = P.ws + WS_OPS + ((size_t)cu * 8 + h) * OPS_UNIT;
        const float gt = GT[cu * 8 + h];
        const bf16x8* Wf = (const bf16x8*)(ops + OPS_W) + lane; const bf16x8* KT = (const bf16x8*)(ops + OPS_KT) + lane;
        const bf16x8* QD = (const bf16x8*)(ops + OPS_QD) + lane; const bf16x8* QK = (const bf16x8*)(ops + OPS_QK) + lane;
        const v2u* Up = (const v2u*)(ops + OPS_U) + (sl * 4) * 64 + lane;
        bf16x8 Sb[2]; Sb[0] = pack8(S[0], S[1]); Sb[1] = pack8(S[2], S[3]);
        f32x4 vn[4];
#pragma unroll
        for (int tau = 0; tau < 4; ++tau) { f32x4 av = {0.f, 0.f, 0.f, 0.f}; av = mfma16(Wf[(2 * tau) * 64], Sb[0], av); av = mfma16(Wf[(2 * tau + 1) * 64], Sb[1], av);
            const v2u ub = Up[tau * 64]; const f32x4 u = {bflo(ub.x), bfhi(ub.x), bflo(ub.y), bfhi(ub.y)}; vn[tau] = u - av; }
        bf16x8 Vb[2]; Vb[0] = pack8(vn[0], vn[1]); Vb[1] = pack8(vn[2], vn[3]);
        f32x4 ao[4];
#pragma unroll
        for (int tau = 0; tau < 4; ++tau) { f32x4 a = {0.f, 0.f, 0.f, 0.f}; a = mfma16(QD[(2 * tau) * 64], Sb[0], a); a = mfma16(QD[(2 * tau + 1) * 64], Sb[1], a);
            a = mfma16(QK[((tau < 2) ? tau : 2 * tau - 2) * 64], Vb[0], a); if (tau >= 2) a = mfma16(QK[(2 * tau - 1) * 64], Vb[1], a); ao[tau] = a; }
#pragma unroll
        for (int tau = 0; tau < 4; ++tau) { f32x4 a = S[tau] * gt; a = mfma16(KT[(2 * tau) * 64], Vb[0], a); a = mfma16(KT[(2 * tau + 1) * 64], Vb[1], a); S[tau] = a; }
        if (!smp) { float* op = OA + ((size_t)s * TP + n * 64) * 512 + h * 64 + e;
#pragma unroll
            for (int tau = 0; tau < 4; ++tau)
#pragma unroll
                for (int r = 0; r < 4; ++r) op[(size_t)(16 * tau + 4 * q4 + r) * 512] = ao[tau][r];
        } else { float* op = OAS + ((size_t)s * 16) * 512 + h * 64 + e;
#pragma unroll
            for (int r = 0; r < 4; ++r) op[(size_t)(4 * q4 + r) * 512] = ao[0][r]; }
    }
    float* so = P.out + (smp ? O_GS : O_GP) + (((size_t)s * 8 + h) * 64) * 64 + e;
#pragma unroll
    for (int tau = 0; tau < 4; ++tau)
#pragma unroll
        for (int r = 0; r < 4; ++r) so[(size_t)(16 * tau + 4 * q4 + r) * 64] = S[tau][r];
}
constexpr int SR_SLOT = 30720, SR_NS = 4, OT_A = 122880, OT_B = 131584, ZT_OFF = 139776;
__device__ __forceinline__ void scan_prompt_wg(const Params& P, LAS unsigned char* lds, int s, int h, int wave, int lane) {
    constexpr int NST = 128;
    const unsigned char* ops0 = P.ws + WS_OPS + ((size_t)(s * 128) * 8 + h) * OPS_UNIT;
    const size_t step_stride = (size_t)8 * OPS_UNIT;
#define SCAN_BAR() do { asm volatile("" ::: "memory"); __builtin_amdgcn_s_barrier(); asm volatile("" ::: "memory"); } while (0)
    if (wave >= 4) {
        const int lw = wave - 4;
        const int np = (lw < 2) ? 8 : 7, p0 = (lw < 2) ? 8 * lw : 16 + 7 * (lw - 2);
        const unsigned char* src = ops0 + (size_t)p0 * 1024 + lane * 16;
#define SCAN_ISSUE(n, slot) do { const unsigned char* s_ = src + (size_t)(n) * step_stride; LAS unsigned char* d_ = lds + (slot) * SR_SLOT + p0 * 1024; \
        _Pragma("unroll") for (int i_ = 0; i_ < 7; ++i_) glds16_asm(s_ + i_ * 1024, d_ + i_ * 1024, true  ); \
        if (lw < 2) glds16_asm(s_ + 7 * 1024, d_ + 7 * 1024, true); } while (0)
        const int ftid = lw * 64 + lane, ft = ftid >> 2, fp = ftid & 3;
        float gg[16];
#pragma unroll
        for (int i = 0; i < 16; ++i) gg[i] = P.gdn_g[16 * fp + i];
        bf16* Mr = (bf16*)(P.ws + WS_MIX) + ((size_t)s * TP + ft) * 1024 + h * 64 + 16 * fp;
        const unsigned char* zsrc = (const unsigned char*)((const bf16*)(P.ws + WS_Z) + ((size_t)s * TP + 16 * lw + (lane >> 3)) * 1024 + h * 64) + (lane & 7) * 16;
#define SCAN_ZISSUE(n) do { const unsigned char* z_ = zsrc + (size_t)(n) * 64 * 2048; LAS unsigned char* d_ = lds + ZT_OFF + ((n) & 1) * 8192 + (2 * lw) * 1024; \
        glds16_asm(z_, d_, false); glds16_asm(z_ + 8 * 2048, d_ + 1024, false); } while (0)
#pragma unroll
        for (int i = 0; i < 16; ++i) asm volatile("" : "+v"(gg[i]));
        SCAN_ZISSUE(0);
        SCAN_ISSUE(0, 0); SCAN_ISSUE(1, 1); SCAN_ISSUE(2, 2);
        if (lw < 2) asm volatile("s_waitcnt vmcnt(16)" ::: "memory"); else asm volatile("s_waitcnt vmcnt(14)" ::: "memory");
        SCAN_BAR();
        int slot = 3;
#pragma unroll 1
        for (int n = 0; n <= NST; ++n) {
            if (n >= 1) {
                const LAS unsigned char* ot = lds + (((n - 1) & 1) ? OT_B : OT_A) + ft * 128 + fp * 32;
                const LAS unsigned char* zt = lds + ZT_OFF + ((n - 1) & 1) * 8192 + ft * 128 + fp * 32;
                float o[16], zf[16]; { float t0[8], t1[8]; unpack8(*(const LAS v4u*)ot, t0); unpack8(*(const LAS v4u*)(ot + 16), t1);
#pragma unroll
                    for (int i = 0; i < 8; ++i) { o[i] = t0[i]; o[8 + i] = t1[i]; }
                    unpack8(*(const LAS v4u*)zt, t0); unpack8(*(const LAS v4u*)(zt + 16), t1);
#pragma unroll
                    for (int i = 0; i < 8; ++i) { zf[i] = t0[i]; zf[8 + i] = t1[i]; } }
                float ss = 0.f;
#pragma unroll
                for (int i = 0; i < 16; ++i) ss += o[i] * o[i];
                ss += __shfl_xor(ss, 1); ss += __shfl_xor(ss, 2);
                const float rstd = __builtin_amdgcn_rsqf(ss * (1.0f / 64.0f) + 1e-6f);
                float r[16];
#pragma unroll
                for (int i = 0; i < 16; ++i) r[i] = o[i] * rstd * gg[i] * siluf(zf[i]);
                bf16* mp = Mr + (size_t)(n - 1) * 64 * 1024;
                v4u w0, w1; w0.x = pk2(r[0], r[1]); w0.y = pk2(r[2], r[3]); w0.z = pk2(r[4], r[5]); w0.w = pk2(r[6], r[7]); w1.x = pk2(r[8], r[9]); w1.y = pk2(r[10], r[11]); w1.z = pk2(r[12], r[13]); w1.w = pk2(r[14], r[15]);
                *(v4u*)mp = w0; *(v4u*)(mp + 8) = w1;
            }
            if (n < NST) {
                asm volatile("s_waitcnt lgkmcnt(0)" ::: "memory");
                if (n + 1 < NST) SCAN_ZISSUE(n + 1);
                if (n + 3 < NST) SCAN_ISSUE(n + 3, slot);
                if (n >= 2 && n + 3 < NST) { if (lw < 2) asm volatile("s_waitcnt vmcnt(20)" ::: "memory"); else asm volatile("s_waitcnt vmcnt(18)" ::: "memory"); }
                else asm volatile("s_waitcnt vmcnt(0)" ::: "memory");
                slot = (slot == SR_NS - 1) ? 0 : slot + 1;
                SCAN_BAR();
            }
        }
#undef SCAN_ZISSUE
#undef SCAN_ISSUE
    } else {
        const int sl = wave, l15 = lane & 15, q4 = lane >> 4, e = 16 * sl + l15;
        f32x4 S[4];
#pragma unroll
        for (int tau = 0; tau < 4; ++tau) S[tau] = (f32x4){0.f, 0.f, 0.f, 0.f};
        const float* GT = (const float*)(P.ws + WS_GT) + (size_t)(s * 128) * 8 + h;
        const v2u* Ug = (const v2u*)(ops0 + OPS_U) + (sl * 4) * 64 + lane;
        v2u ua[4], ub[4];
#pragma unroll
        for (int tau = 0; tau < 4; ++tau) { ua[tau] = Ug[tau * 64]; ub[tau] = (Ug + step_stride / 8)[tau * 64]; }
        SCAN_BAR();
        int slot = 0;
        float gt = GT[0];
#pragma unroll 1
        for (int n = 0; n < NST; ++n) {
            const LAS unsigned char* ops = lds + slot * SR_SLOT;
            const float gtn = (n + 1 < NST) ? GT[(size_t)(n + 1) * 8] : 0.f;
            v2u uc[4];
#pragma unroll
            for (int tau = 0; tau < 4; ++tau) uc[tau] = (n + 2 < NST) ? (Ug + (size_t)(n + 2) * (step_stride / 8))[tau * 64] : (v2u){0u, 0u};
            const LAS bf16x8* Wf = (const LAS bf16x8*)(ops + OPS_W) + lane; const LAS bf16x8* KT = (const LAS bf16x8*)(ops + OPS_KT) + lane;
            const LAS bf16x8* QD = (const LAS bf16x8*)(ops + OPS_QD) + lane; const LAS bf16x8* QK = (const LAS bf16x8*)(ops + OPS_QK) + lane;
            bf16x8 Sb[2]; Sb[0] = pack8(S[0], S[1]); Sb[1] = pack8(S[2], S[3]);
            f32x4 vn[4];
#pragma unroll
            for (int tau = 0; tau < 4; ++tau) { f32x4 av = {0.f, 0.f, 0.f, 0.f}; av = mfma16(Wf[(2 * tau) * 64], Sb[0], av); av = mfma16(Wf[(2 * tau + 1) * 64], Sb[1], av);
                const f32x4 u = {bflo(ua[tau].x), bfhi(ua[tau].x), bflo(ua[tau].y), bfhi(ua[tau].y)}; vn[tau] = u - av; }
            bf16x8 Vb[2]; Vb[0] = pack8(vn[0], vn[1]); Vb[1] = pack8(vn[2], vn[3]);
            f32x4 ao[4];
#pragma unroll
            for (int tau = 0; tau < 4; ++tau) { f32x4 a = {0.f, 0.f, 0.f, 0.f}; a = mfma16(QD[(2 * tau) * 64], Sb[0], a); a = mfma16(QD[(2 * tau + 1) * 64], Sb[1], a);
                a = mfma16(QK[((tau < 2) ? tau : 2 * tau - 2) * 64], Vb[0], a); if (tau >= 2) a = mfma16(QK[(2 * tau - 1) * 64], Vb[1], a); ao[tau] = a; }
#pragma unroll
            for (int tau = 0; tau < 4; ++tau) { f32x4 a = S[tau] * gt; a = mfma16(KT[(2 * tau) * 64], Vb[0], a); a = mfma16(KT[(2 * tau + 1) * 64], Vb[1], a); S[tau] = a; }
            LAS unsigned char* ot = lds + ((n & 1) ? OT_B : OT_A) + e * 2;
#pragma unroll
            for (int tau = 0; tau < 4; ++tau)
#pragma unroll
                for (int r = 0; r < 4; ++r) *(LAS unsigned short*)(ot + (16 * tau + 4 * q4 + r) * 128) = (unsigned short)(pk2(ao[tau][r], 0.f) & 0xffffu);
            gt = gtn;
#pragma unroll
            for (int tau = 0; tau < 4; ++tau) { ua[tau] = ub[tau]; ub[tau] = uc[tau]; }
            slot = (slot == SR_NS - 1) ? 0 : slot + 1;
            asm volatile("s_waitcnt lgkmcnt(0)" ::: "memory");
            SCAN_BAR();
        }
        float* so = P.out + O_GP + (((size_t)s * 8 + h) * 64) * 64 + e;
#pragma unroll
        for (int tau = 0; tau < 4; ++tau)
#pragma unroll
            for (int r = 0; r < 4; ++r) so[(size_t)(16 * tau + 4 * q4 + r) * 64] = S[tau][r];
    }
#undef SCAN_BAR
}
#ifdef PROBE_PREFIX
#define PROBE_NOEXP (P.flags & 4096)
#define PROBE_NOPV (P.flags & 8192)
#else
#define PROBE_NOEXP 0
#define PROBE_NOPV 0
#endif
constexpr int TAB_LD = 704, TAB_OFF = 131584;
__device__ __forceinline__ float wave_max(float v) {
#pragma unroll
    for (int o = 1; o < 64; o <<= 1) v = fmaxf(v, __shfl_xor(v, o));
    return v;
}
__device__ __forceinline__ void attn_setup(const Params& P, LAS unsigned char* lds, int tid) {
    LAS float* tab = (LAS float*)(lds + TAB_OFF); LAS float* mh = tab + 8 * TAB_LD;
    const int lane = tid & 63, h = tid >> 6;
    const float gq = wave_max(fabsf(P.qn_g[lane])), gk = wave_max(fabsf(P.kn_g[lane]));
    float tb = -1e30f;
    for (int i = lane; i < 257; i += 64) tb = fmaxf(tb, P.rel_bias[h * 257 + i]);
    tb = wave_max(tb);
    if (lane == 0) mh[h] = 8.0f * gq * gk + tb;
    __syncthreads();
    { float tv[11];
#pragma unroll
      for (int k = 0; k < 11; ++k) { const int idx = tid + 512 * k, hh = idx / TAB_LD, r = idx - hh * TAB_LD; tv[k] = P.rel_bias[hh * 257 + (r > 256 ? 256 : r)]; }
#pragma unroll
      for (int k = 0; k < 11; ++k) { const int idx = tid + 512 * k, hh = idx / TAB_LD; tab[idx] = (tv[k] - mh[hh]) * 1.44269504089f; } }
    __syncthreads();
}
__device__ __forceinline__ void attn_unit(const Params& P, const LAS float* tabh, LAS unsigned char* ring, int cu, int h, int lane) {
    const bool smp = cu >= 1024; const int s = smp ? cu - 1024 : cu >> 7; const int c = smp ? 0 : cu & 127;
    const int l31 = lane & 31, hh = lane >> 5;
    const unsigned char* yscr = (const unsigned char*)P.out;
    const unsigned char* qb_ = smp ? P.ws + WS_QFS + ((size_t)(s * 2) * 8 + h) * 4096 : P.ws + WS_QF + ((size_t)(s * 256 + 2 * c) * 8 + h) * 4096;
    const long kblk0 = smp ? (long)s * 18 : (long)s * 256 + 2 * (c - 8);
    const unsigned char* kb_ = (smp ? P.ws + WS_KFS : yscr + YO_KF) + h * 4096;
    const unsigned char* vb_ = (smp ? P.ws + WS_VFS : yscr + YO_VF) + h * 4096;
    bf16x8 qf[2][4];
#pragma unroll
    for (int qb = 0; qb < 2; ++qb)
#pragma unroll
        for (int kk = 0; kk < 4; ++kk) qf[qb][kk] = *(const bf16x8*)(qb_ + (size_t)qb * 32768 + kk * 1024 + lane * 16);
    f32x16 oacc[2][2]; float lsum[2] = {0.f, 0.f};
#pragma unroll
    for (int qb = 0; qb < 2; ++qb)
#pragma unroll
        for (int dt = 0; dt < 2; ++dt)
#pragma unroll
            for (int r = 0; r < 16; ++r) oacc[qb][dt][r] = 0.f;
    const int j_lo = smp ? 0 : (c < 8 ? 2 * (8 - c) : 0), j_hi = smp ? 17 : 18;
    f32x16 cbias;
    { const float bconst = tabh[256];
#pragma unroll
      for (int r = 0; r < 16; ++r) cbias[r] = bconst; }
#define ATT_DMA(jj, sl) do { const unsigned char* kp_ = kb_ + (size_t)(kblk0 + (jj)) * 32768 + lane * 16; const unsigned char* vp_ = vb_ + (size_t)(kblk0 + (jj)) * 32768 + lane * 16; \
        LAS unsigned char* d_ = ring + (sl) * 8192; \
        _Pragma("unroll") for (int kk = 0; kk < 4; ++kk) glds16_asm(kp_ + kk * 1024, d_ + kk * 1024, false); \
        _Pragma("unroll") for (int kk = 0; kk < 4; ++kk) glds16_asm(vp_ + kk * 1024, d_ + 4096 + kk * 1024, false); } while (0)
#define ATT_ZDMA(sl) do { int ln_ = lane; asm volatile("" : "+v"(ln_));     \
        const int tk_ = ln_ >> 3, ch_ = (ln_ & 7) ^ tk_; LAS unsigned char* d_ = ring + (sl) * 8192; \
        _Pragma("unroll") for (int p_ = 0; p_ < 8; ++p_) { const int tok_ = smp ? ((8 * p_ + tk_) & 15) : (8 * p_ + tk_); \
            glds16_asm(zbase + (size_t)tok_ * 2048 + ch_ * 16, d_ + p_ * 1024, false); } } while (0)
#define ATT_BODY(KF, VF, jj) do { const int kt = (jj) >> 1, half = (jj) & 1; \
        _Pragma("unroll") for (int qb = 0; qb < 2; ++qb) { \
            f32x16 sa; \
            if (kt <= 5) { sa = mfma32(KF[0], qf[qb][0], cbias); } \
            else { const LAS float* tp_ = tabh + (512 - 64 * kt - 32 * half + 32 * qb + l31 - 4 * hh + 128 - 27); f32x16 bi; \
                _Pragma("unroll") for (int r = 0; r < 16; ++r) bi[r] = tp_[27 - ((r & 3) + 8 * (r >> 2))]; \
                sa = mfma32(KF[0], qf[qb][0], bi); } \
            _Pragma("unroll") for (int kk = 1; kk < 4; ++kk) sa = mfma32(KF[kk], qf[qb][kk], sa); \
            float p[16]; \
            _Pragma("unroll") for (int r = 0; r < 16; ++r) p[r] = PROBE_NOEXP ? sa[r] : __builtin_amdgcn_exp2f(sa[r]); \
            if (smp && (jj) == 16) { \
                _Pragma("unroll") for (int r = 8; r < 16; ++r) p[r] = 0.f; \
            } \
            { typedef float f32x2_ __attribute__((ext_vector_type(2))); f32x2_ a2 = {p[0], p[1]}, b2 = {p[2], p[3]}; \
              _Pragma("unroll") for (int r = 4; r < 16; r += 4) { a2 += (f32x2_){p[r], p[r + 1]}; b2 += (f32x2_){p[r + 2], p[r + 3]}; } \
              a2 += b2; lsum[qb] += a2.x + a2.y; } \
            v4u w0, w1; w0.x = pk2(p[0], p[1]); w0.y = pk2(p[2], p[3]); w0.z = pk2(p[4], p[5]); w0.w = pk2(p[6], p[7]); w1.x = pk2(p[8], p[9]); w1.y = pk2(p[10], p[11]); w1.z = pk2(p[12], p[13]); w1.w = pk2(p[14], p[15]); \
            const bf16x8 pb0 = __builtin_bit_cast(bf16x8, w0), pb1 = __builtin_bit_cast(bf16x8, w1); \
            if (PROBE_NOPV) { asm volatile("" :: "v"(pb0), "v"(pb1)); } else { \
            _Pragma("unroll") for (int dt = 0; dt < 2; ++dt) { oacc[qb][dt] = mfma32(VF[dt * 2 + 0], pb0, oacc[qb][dt]); oacc[qb][dt] = mfma32(VF[dt * 2 + 1], pb1, oacc[qb][dt]); } } \
        } } while (0)
    int zsl = 0;
    const size_t m0u = smp ? (size_t)MP + s * 16 : (size_t)s * TP + c * 64;
    const unsigned char* zbase = (const unsigned char*)((const bf16*)(P.ws + WS_Z) + m0u * 1024 + 512 + h * 64);
    {
#ifdef PROBE_PREFIX
        const int nb = (P.flags & 16384) ? 2 : (j_hi - j_lo);
#else
        const int nb = j_hi - j_lo;
#endif
        const bool rot = (!smp) && (c >= 8); const int rsh = 8 - (c % 9) + 9;
#define ATT_J(i) (rot ? (2 * ((((i) >> 1) + rsh) % 9) + ((i) & 1)) : (j_lo + (i)))
        bf16x8 kf[4], vf[4];
#ifdef PROBE_PREFIX
        if (!(P.flags & 4)) {
#endif
        ATT_DMA(ATT_J(0), 0);
        if (1 < nb) ATT_DMA(ATT_J(1), 1);
#ifdef PROBE_PREFIX
        }
#endif
#pragma unroll
        for (int qb = 0; qb < 2; ++qb)
#pragma unroll
            for (int kk = 0; kk < 4; ++kk) asm volatile("" : "+v"(qf[qb][kk]));
        int sl = 0;
#pragma unroll 1
        for (int i = 0; i < nb; ++i) {
            if (i + 1 < nb) asm volatile("s_waitcnt vmcnt(8)" ::: "memory"); else asm volatile("s_waitcnt vmcnt(0)" ::: "memory");
            const LAS unsigned char* sp = ring + sl * 8192 + lane * 16;
#pragma unroll
            for (int kk = 0; kk < 4; ++kk) { kf[kk] = *(const LAS bf16x8*)(sp + kk * 1024); vf[kk] = *(const LAS bf16x8*)(sp + 4096 + kk * 1024); }
            asm volatile("s_waitcnt lgkmcnt(0)" ::: "memory");
#ifdef PROBE_PREFIX
            if (i + 2 < nb && !(P.flags & 4)) { const int j2 = ATT_J(i + 2); ATT_DMA(j2, sl); } else if (i + 2 == nb) { ATT_ZDMA(sl); zsl = sl; }
            const int j = ATT_J(i);
            if (!(P.flags & 8)) ATT_BODY(kf, vf, j);
#else
            if (i + 2 < nb) { const int j2 = ATT_J(i + 2); ATT_DMA(j2, sl); } else if (i + 2 == nb) { ATT_ZDMA(sl); zsl = sl; }
            const int j = ATT_J(i);
            ATT_BODY(kf, vf, j);
#endif
            sl ^= 1;
        }
#undef ATT_J
    }
#undef ATT_DMA
#undef ATT_BODY
    {
        const LAS unsigned char* zt = ring + zsl * 8192; LAS unsigned char* ot = ring + (zsl ^ 1) * 8192;
#pragma unroll
        for (int qb = 0; qb < 2; ++qb) {
            const float l = lsum[qb] + __shfl_xor(lsum[qb], 32); const float inv = __builtin_amdgcn_rcpf(l);
            const int tq = 32 * qb + l31;
#ifdef PROBE_PREFIX
            if (!(P.flags & 16))
#endif
#pragma unroll
            for (int dt = 0; dt < 2; ++dt)
#pragma unroll
                for (int rg = 0; rg < 4; ++rg) { const int cc = 4 * dt + rg; const int off = tq * 128 + ((cc ^ (tq & 7)) * 16) + 8 * hh;
                    const v2u zb = *(const LAS v2u*)(zt + off);
                    v2u o; o.x = pk2(oacc[qb][dt][4 * rg] * inv * siluf(bflo(zb.x)), oacc[qb][dt][4 * rg + 1] * inv * siluf(bfhi(zb.x)));
                    o.y = pk2(oacc[qb][dt][4 * rg + 2] * inv * siluf(bflo(zb.y)), oacc[qb][dt][4 * rg + 3] * inv * siluf(bfhi(zb.y)));
                    *(LAS v2u*)(ot + off) = o; }
        }
        bf16* mixb = (bf16*)(P.ws + WS_MIX) + m0u * 1024 + 512 + h * 64;
        const int tk = lane >> 3, ch = lane & 7;
#pragma unroll
        for (int p = 0; p < 8; ++p) { const int tok = 8 * p + tk;
            const v4u w = *(const LAS v4u*)(ot + tok * 128 + ((ch ^ (tok & 7)) * 16));
            if (!smp || tok < 16) *(v4u*)(mixb + (size_t)tok * 1024 + ch * 8) = w; }
        asm volatile("s_waitcnt lgkmcnt(0)" ::: "memory");
    }
}
constexpr int AG_R = 14, AG_D = 6;
__device__ __forceinline__ void attn_group(const Params& P, LAS unsigned char* lds, const LAS float* tabh, int s, int h, int c0, int wave, int lane) {
    const int pi = wave >> 1, qb = wave & 1, c = c0 + pi, l31 = lane & 31, hh = lane >> 5;
    const unsigned char* yscr = (const unsigned char*)P.out;
    const long kblk0 = (long)s * 256 + 2 * (c0 - 8);
    const unsigned char* src = yscr + (wave < 4 ? YO_KF : YO_VF) + (size_t)h * 4096 + (size_t)(wave & 3) * 1024 + lane * 16;
    LAS unsigned char* dstw = lds + (wave < 4 ? 0 : 4096) + (wave & 3) * 1024;
    const int pos_lo = (c0 < 8) ? 2 * (8 - c0) : 0;
    const bool fast = (c0 >= 8);
#ifdef PROBE_PREFIX
#define AG_BAR() do { asm volatile("" ::: "memory"); if (!(P.flags & 524288)) __builtin_amdgcn_s_barrier(); asm volatile("" ::: "memory"); } while (0)
#define AG_NODMA (P.flags & 262144)
#define AG_NOBODY (P.flags & 131072)
#else
#define AG_BAR() do { asm volatile("" ::: "memory"); __builtin_amdgcn_s_barrier(); asm volatile("" ::: "memory"); } while (0)
#define AG_NODMA 0
#define AG_NOBODY 0
#endif
    bf16x8 qf[4];
    { const unsigned char* qp = P.ws + WS_QF + ((size_t)(s * 256 + 2 * c + qb) * 8 + h) * 4096 + lane * 16;
#pragma unroll
      for (int kk = 0; kk < 4; ++kk) qf[kk] = *(const bf16x8*)(qp + kk * 1024);
#pragma unroll
      for (int kk = 0; kk < 4; ++kk) asm volatile("" : "+v"(qf[kk])); }
    f32x16 cbias;
    { const float bconst = tabh[256];
#pragma unroll
      for (int r = 0; r < 16; ++r) cbias[r] = bconst; }
    f32x16 oacc[2]; float lsum = 0.f;
#pragma unroll
    for (int dt = 0; dt < 2; ++dt)
#pragma unroll
        for (int r = 0; r < 16; ++r) oacc[dt][r] = 0.f;
#pragma unroll 1
    for (int p = 0; p <= 6 + AG_D; ++p) if (p >= pos_lo && !AG_NODMA) glds16_asm(src + (size_t)(kblk0 + p) * 32768, dstw + (p % AG_R) * 8192, false);
    if (fast) asm volatile("s_waitcnt vmcnt(6)" ::: "memory"); else asm volatile("s_waitcnt vmcnt(0)" ::: "memory");
    AG_BAR();
#pragma unroll 1
    for (int t = 0; t < 18; ++t) {
        { const int pn = t + 7 + AG_D; if (pn < 24 && pn >= pos_lo && !AG_NODMA) glds16_asm(src + (size_t)(kblk0 + pn) * 32768, dstw + (pn % AG_R) * 8192, false); }
        const int p = 2 * pi + t;
        if (p >= pos_lo && !AG_NOBODY) {
            const LAS unsigned char* sp = lds + (p % AG_R) * 8192 + lane * 16;
            bf16x8 kf[4], vf[4];
#pragma unroll
            for (int kk = 0; kk < 4; ++kk) { kf[kk] = *(const LAS bf16x8*)(sp + kk * 1024); vf[kk] = *(const LAS bf16x8*)(sp + 4096 + kk * 1024); }
            const int kt = t >> 1, half = t & 1;
            f32x16 sa;
            if (kt <= 5) sa = mfma32(kf[0], qf[0], cbias);
            else { const LAS float* tp_ = tabh + (512 - 64 * kt - 32 * half + 32 * qb + l31 - 4 * hh + 128 - 27); f32x16 bi;
#pragma unroll
                for (int r = 0; r < 16; ++r) bi[r] = tp_[27 - ((r & 3) + 8 * (r >> 2))];
                sa = mfma32(kf[0], qf[0], bi); }
#pragma unroll
            for (int kk = 1; kk < 4; ++kk) sa = mfma32(kf[kk], qf[kk], sa);
            float pr[16];
#pragma unroll
            for (int r = 0; r < 16; ++r) pr[r] = __builtin_amdgcn_exp2f(sa[r]);
            { typedef float f32x2_ __attribute__((ext_vector_type(2))); f32x2_ a2 = {pr[0], pr[1]}, b2 = {pr[2], pr[3]};
#pragma unroll
              for (int r = 4; r < 16; r += 4) { a2 += (f32x2_){pr[r], pr[r + 1]}; b2 += (f32x2_){pr[r + 2], pr[r + 3]}; }
              a2 += b2; lsum += a2.x + a2.y; }
            v4u w0, w1; w0.x = pk2(pr[0], pr[1]); w0.y = pk2(pr[2], pr[3]); w0.z = pk2(pr[4], pr[5]); w0.w = pk2(pr[6], pr[7]); w1.x = pk2(pr[8], pr[9]); w1.y = pk2(pr[10], pr[11]); w1.z = pk2(pr[12], pr[13]); w1.w = pk2(pr[14], pr[15]);
            const bf16x8 pb0 = __builtin_bit_cast(bf16x8, w0), pb1 = __builtin_bit_cast(bf16x8, w1);
#pragma unroll
            for (int dt = 0; dt < 2; ++dt) { oacc[dt] = mfma32(vf[dt * 2 + 0], pb0, oacc[dt]); oacc[dt] = mfma32(vf[dt * 2 + 1], pb1, oacc[dt]); }
        }
        asm volatile("s_waitcnt lgkmcnt(0)" ::: "memory");
        if (fast && t + 7 + AG_D < 24) asm volatile("s_waitcnt vmcnt(6)" ::: "memory"); else asm volatile("s_waitcnt vmcnt(0)" ::: "memory");
        AG_BAR();
    }
#undef AG_BAR
    {
        const float l = lsum + __shfl_xor(lsum, 32); const float inv = __builtin_amdgcn_rcpf(l);
        const size_t mrow = (size_t)s * TP + c * 64 + 32 * qb + l31;
        const bf16* Z = (const bf16*)(P.ws + WS_Z); bf16* MIX = (bf16*)(P.ws + WS_MIX);
#pragma unroll
        for (int dt = 0; dt < 2; ++dt)
#pragma unroll
            for (int rg = 0; rg < 4; ++rg) { const int d0 = 32 * dt + 8 * rg + 4 * hh; const size_t off = mrow * 1024 + 512 + h * 64 + d0;
                const v2u zb = *(const v2u*)(Z + off);
                v2u o; o.x = pk2(oacc[dt][4 * rg] * inv * siluf(bflo(zb.x)), oacc[dt][4 * rg + 1] * inv * siluf(bfhi(zb.x))); o.y = pk2(oacc[dt][4 * rg + 2] * inv * siluf(bflo(zb.y)), oacc[dt][4 * rg + 3] * inv * siluf(bfhi(zb.y)));
                *(v2u*)(MIX + off) = o; }
    }
}
template <int RT, class F>
__device__ __forceinline__ void sample_gemm_task(const bf16* A, const bf16* Bt, int K, int ct, int row0, int lane, F f) {
    const int l15 = lane & 15, q4 = lane >> 4;
    f32x4 acc[RT];
#pragma unroll
    for (int rt = 0; rt < RT; ++rt) acc[rt] = (f32x4){0.f, 0.f, 0.f, 0.f};
    const bf16* bp = Bt + (size_t)(16 * ct + l15) * K + 8 * q4;
    const bf16* ap = A + (size_t)(row0 + l15) * K + 8 * q4;
#pragma unroll 4
    for (int ks = 0; ks < K / 32; ++ks) { const bf16x8 b = *(const bf16x8*)(bp + 32 * ks);
#pragma unroll
        for (int rt = 0; rt < RT; ++rt) { const bf16x8 a = *(const bf16x8*)(ap + (size_t)(16 * rt) * K + 32 * ks); acc[rt] = mfma16(a, b, acc[rt]); } }
#pragma unroll
    for (int rt = 0; rt < RT; ++rt)
#pragma unroll
        for (int r = 0; r < 4; ++r) f(row0 + 16 * rt + 4 * q4 + r, 16 * ct + l15, acc[rt][r]);
}
struct SEpiProj { bf16* qkva; bf16* qkvb; bf16* z;
    __device__ __forceinline__ void operator()(int row, int n, float v) const { const size_t m = (size_t)MP + row; const bf16 b = (bf16)(pk2(v, 0.f) & 0xffffu);
        if (n < 1536) qkva[m * 1536 + n] = b; else if (n < 3072) qkvb[m * 1536 + (n - 1536)] = b; else z[m * 1024 + (n - 3072)] = b; } };
struct SEpiOut { const float* xs; bf16* h1b;
    __device__ __forceinline__ void operator()(int row, int n, float v) const { const size_t m = (size_t)MP + row; const float h = xs[(size_t)row * 1024 + n] + v; h1b[m * 1024 + n] = (bf16)(pk2(h, 0.f) & 0xffffu); } };
struct SEpiE { bf16* E; float* ssq;
    __device__ __forceinline__ void operator()(int row, int n, float v) const { const size_t m = (size_t)MP + row; E[m * 1024 + n] = (bf16)(pk2(v, 0.f) & 0xffffu);
        float s = v * v; s += __shfl_xor(s, 1); s += __shfl_xor(s, 2); s += __shfl_xor(s, 4); s += __shfl_xor(s, 8);
        if ((threadIdx.x & 15) == 0) atomicAdd(ssq + m, s); } };
struct SEpiGate { float* y; const bf16* h1b; const bf16* E; const float* ssq; const float* pg;
    __device__ __forceinline__ void operator()(int row, int n, float v) const { const size_t m = (size_t)MP + row; const float rstd = 1.0f / sqrtf(ssq[m] * (1.0f / 1024.0f) + 1e-6f);
        const float sg = __builtin_amdgcn_rcpf(1.0f + __expf(-v)); y[m * 1024 + n] = bf1(h1b[m * 1024 + n]) + sg * (bf1(E[m * 1024 + n]) * rstd * pg[n]); } };
__device__ __forceinline__ void gate_tile(const Params& P, int tile, int lane) {
    const int l15 = lane & 15, q4 = lane >> 4;
    const bf16* ap = (const bf16*)(P.ws + WS_XN) + (size_t)(16 * tile + l15) * 1024 + 8 * q4;
    const bf16* bp = (const bf16*)(P.ws + WS_WAB) + (size_t)l15 * 1024 + 8 * q4;
    f32x4 acc = {0.f, 0.f, 0.f, 0.f};
#pragma unroll 8
    for (int ks = 0; ks < 32; ++ks) acc = mfma16(*(const bf16x8*)(ap + 32 * ks), *(const bf16x8*)(bp + 32 * ks), acc);
    float* Gd = (float*)(P.ws + WS_G); float* Bd = (float*)(P.ws + WS_BETA);
    const int c = l15;
    const float al = (c < 8) ? -expf(P.a_log[c]) : 0.f, db = (c < 8) ? P.dt_bias[c] : 0.f;
#pragma unroll
    for (int r = 0; r < 4; ++r) { const size_t mrow = (size_t)16 * tile + 4 * q4 + r; const float v = acc[r];
        if (c < 8) { const float xx = v + db; const float sp = xx > 20.f ? xx : log1pf(expf(xx)); Gd[mrow * 8 + c] = al * sp; }
        else Bd[mrow * 8 + (c - 8)] = 1.0f / (1.0f + expf(-v)); }
}
__device__ __forceinline__ void phase4(const Params& P, int lane, int wave, int G) {
    const int gw = blockIdx.x * NWAVES + wave, NGW = G * NWAVES;
    const float* OA = (const float*)((const unsigned char*)P.out + YO_OA); const float* OAS = (const float*)(P.ws + WS_OAS);
    const bf16* Z = (const bf16*)(P.ws + WS_Z); bf16* MIX = (bf16*)(P.ws + WS_MIX);
    float gg[8];
#pragma unroll
    for (int i = 0; i < 8; ++i) gg[i] = P.gdn_g[(8 * lane + i) & 63];
    for (int m = gw; m < M; m += NGW) {
        const float* orow = m < MP ? OA + (size_t)m * 512 : OAS + (size_t)(m - MP) * 512;
        const f32x4 a = ((const f32x4*)orow)[2 * lane], b = ((const f32x4*)orow)[2 * lane + 1];
        float f[8] = {a[0], a[1], a[2], a[3], b[0], b[1], b[2], b[3]};
        float ss = 0.f;
#pragma unroll
        for (int i = 0; i < 8; ++i) ss += f[i] * f[i];
        ss += __shfl_xor(ss, 1); ss += __shfl_xor(ss, 2); ss += __shfl_xor(ss, 4);
        const float rstd = __builtin_amdgcn_rsqf(ss * (1.0f / 64.0f) + 1e-6f);
        const v4u zw = *(const v4u*)(Z + (size_t)m * 1024 + 8 * lane); float z[8]; unpack8(zw, z);
#pragma unroll
        for (int i = 0; i < 8; ++i) f[i] = f[i] * rstd * gg[i] * siluf(z[i]);
        *(v4u*)(MIX + (size_t)m * 1024 + 8 * lane) = packf8(f);
    }
}
constexpr int N_PHASES = 7;
__global__ void __launch_bounds__(NWAVES * 64, 2) fwd_kernel(Params P) {
    extern __shared__ __attribute__((aligned(16))) unsigned char lds_raw[];
    LAS unsigned char* lds = (LAS unsigned char*)lds_raw;
    volatile LAS unsigned* MISC = (volatile LAS unsigned*)(lds + MISC_OFF);
    const int G = gridDim.x;
#define PHASE_IDS int tid = threadIdx.x; asm volatile("" : "+v"(tid)); const int lane = tid & 63, wave = __builtin_amdgcn_readfirstlane(tid >> 6); (void)lane; (void)wave
    { PHASE_IDS;
    for (int u = tid; u < (LDS_BYTES - LDSCTL_OFF) / 4; u += NWAVES * 64) ((LAS unsigned*)(lds + LDSCTL_OFF))[u] = 0u; }
    __syncthreads();
    unsigned char* ws = P.ws;
    const int lo = P.ph_lo, hi = P.ph_hi;
    const bool multi = (hi - lo) > 1;
    XcdBarrier bar; bar.bar = (unsigned*)(ws + WS_CTL) + CW_BAR; bar.x = 0; bar.st = nullptr;
    if (multi) bar = xcd_barrier_post((unsigned*)(ws + WS_CTL) + CW_BAR, MISC + 8);
#ifndef PROBE_REP
#define PROBE_REP -1
#endif
#define IN(k) (lo <= (k) && (k) < hi)
#define REP(k) _Pragma("unroll") for (int rep_ = 0; rep_ < ((PROBE_REP == (k)) ? 2 : 1); ++rep_)
#define SEAM(k) do { if (IN(k) && IN((k) + 1)) xcd_barrier(bar); } while (0)
    if (IN(0)) REP(0) { PHASE_IDS; phase0(P, lds, tid, lane, wave, G); __syncthreads(); }
    SEAM(0);
    if (IN(1)) REP(1) { PHASE_IDS;
        pg8::Gemm g{(const pg8::bf16_t*)(ws + WS_XN), (const pg8::bf16_t*)(ws + WS_WIN), MP, 4096, 1024}; pg8::StaticOrder S;
#ifdef PROBE_PREFIX
        S.init((P.flags & 1048576) ? MP / 4 : MP, 4096, G, (int)blockIdx.x);
#else
        S.init(MP, 4096, G, (int)blockIdx.x);
#endif
        pg8::EpiProj E{(pg8::bf16_t*)(ws + WS_QKVA), (pg8::bf16_t*)(ws + WS_QKVB), (pg8::bf16_t*)(ws + WS_Z)};
        pg8::gemm_phase<pg8::EpiProj, pg8::StaticOrder, PG8_ALIGN, PG8_SP2>(lds, g, S, E);
        for (int tl = (int)blockIdx.x * NWAVES + wave; tl < M / 16; tl += G * NWAVES) gate_tile(P, tl, lane);
        for (int ct = blockIdx.x; ct < 256; ct += G)
            sample_gemm_task<2>((const bf16*)(ws + WS_XN) + (size_t)MP * 1024, (const bf16*)(ws + WS_WIN), 1024, ct, 32 * wave, lane, SEpiProj{(bf16*)(ws + WS_QKVA), (bf16*)(ws + WS_QKVB), (bf16*)(ws + WS_Z)});
    }
    SEAM(1);
    if (IN(2)) REP(2) { PHASE_IDS;
        if (!(P.flags & 32)) REP(20) { gdn_prep_all(P, lds, tid, lane, wave, G);
        __syncthreads(); }
        conv_state_out(P, tid, G);
    }
    SEAM(2);
    if (IN(3)) REP(3) { PHASE_IDS;
        const int NSC = 64;
        unsigned* bpc = (unsigned*)(ws + WS_CTL) + CW_BP;
        if ((int)blockIdx.x < NSC && !(P.flags & 1)) {
            REP(30) { scan_prompt_wg(P, lds, (int)blockIdx.x >> 3, (int)blockIdx.x & 7, wave, lane); __syncthreads(); }
            { const int pr = (int)blockIdx.x * 2 + (wave >> 2); scan_chain(P, true, pr >> 3, pr & 7, wave & 3, lane); }
            asm volatile("s_waitcnt vmcnt(0)" ::: "memory"); __syncthreads();
            {
                const int pr = (int)blockIdx.x * 2 + (tid >> 8), sp = pr >> 3, hp_ = pr & 7, t = (tid >> 4) & 15, part = tid & 15;
                const size_t row = (size_t)sp * 16 + t;
                const f32x4 o4 = *(const f32x4*)((const float*)(ws + WS_OAS) + row * 512 + hp_ * 64 + 4 * part);
                float ss = (o4[0] * o4[0] + o4[1] * o4[1]) + (o4[2] * o4[2] + o4[3] * o4[3]);
                ss += __shfl_xor(ss, 1); ss += __shfl_xor(ss, 2); ss += __shfl_xor(ss, 4); ss += __shfl_xor(ss, 8);
                const float rstd = __builtin_amdgcn_rsqf(ss * (1.0f / 64.0f) + 1e-6f);
                const size_t mo = ((size_t)MP + row) * 1024 + hp_ * 64 + 4 * part;
                const v2u zb = *(const v2u*)((const bf16*)(ws + WS_Z) + mo);
                const f32x4 g4 = *(const f32x4*)(P.gdn_g + 4 * part);
                v2u o; o.x = pk2(o4[0] * rstd * g4[0] * siluf(bflo(zb.x)), o4[1] * rstd * g4[1] * siluf(bfhi(zb.x))); o.y = pk2(o4[2] * rstd * g4[2] * siluf(bflo(zb.y)), o4[3] * rstd * g4[3] * siluf(bfhi(zb.y)));
                *(v2u*)((bf16*)(ws + WS_MIX) + mo) = o;
            }
            __syncthreads();
        } else if ((int)blockIdx.x >= NSC) {
            if (!(P.flags & 64)) REP(21) for (int it = (int)blockIdx.x - NSC; it < NCU + NBS * 8; it += G - NSC) bprep_item(P, lds, it, tid, lane, wave);
            asm volatile("s_waitcnt vmcnt(0)" ::: "memory"); __syncthreads();
            if (tid == 0) { __builtin_amdgcn_fence(__ATOMIC_RELEASE, "agent"); asm volatile("s_waitcnt vmcnt(0)" ::: "memory"); (void)__hip_atomic_fetch_add(bpc, 1u, __ATOMIC_RELAXED, __HIP_MEMORY_SCOPE_AGENT); }
        }
        {
            if (tid == 0) { const unsigned want = (unsigned)(G - NSC); unsigned sp_ = 0; unsigned* tmo = (unsigned*)(ws + WS_CTL) + CW_BAR + XB_TMO;
                while (__hip_atomic_load(bpc, __ATOMIC_RELAXED, __HIP_MEMORY_SCOPE_AGENT) < want) { __builtin_amdgcn_s_sleep(2);
                    if ((++sp_ & 255u) == 0u) { if (__hip_atomic_load(tmo, __ATOMIC_RELAXED, __HIP_MEMORY_SCOPE_AGENT)) break; if (sp_ > (1u << 20)) { atomicAdd(tmo, 1u); break; } } }
                __builtin_amdgcn_fence(__ATOMIC_ACQUIRE, "agent"); asm volatile("s_waitcnt vmcnt(0)" ::: "memory"); }
            __syncthreads();
        }
        attn_setup(P, lds, tid);
#ifdef PROBE_PREFIX
        if (P.flags & 32768) {
            f32x4 acc = {0.f, 0.f, 0.f, 0.f}; bf16x8 a = {1, 2, 3, 4, 5, 6, 7, 8}, b = {1, 1, 1, 1, 1, 1, 1, 1};
            for (int i = 0; i < 20000; ++i) acc = mfma16(a, b, acc);
            if (acc[0] == 123.456f) ((float*)(ws + WS_OAS))[tid] = acc[0];
        }
        if (P.flags & 65536) {
            float x = (float)tid * 1e-9f;
            for (int i = 0; i < 200000; ++i) x = __builtin_fmaf(x, 0.999f, 1e-7f);
            if (x == 123.456f) ((float*)(ws + WS_OAS))[tid] = x;
        }
#endif
        if (!(P.flags & 2)) REP(31) {
            unsigned* ctr = (unsigned*)(ws + WS_CTL) + CW_ATT + (rep_ ? 64 * 16 : 0);
            volatile LAS unsigned* tk = (volatile LAS unsigned*)(lds + TAB_OFF + 8 * TAB_LD * 4 + 64);
            unsigned nxt = 0;
            if (tid == 0) { tk[0] = __hip_atomic_fetch_add(ctr, 1u, __ATOMIC_RELAXED, __HIP_MEMORY_SCOPE_AGENT); nxt = __hip_atomic_fetch_add(ctr, 1u, __ATOMIC_RELAXED, __HIP_MEMORY_SCOPE_AGENT); }
            for (;;) {
                __syncthreads();
                const unsigned b = tk[0];
                __syncthreads();
                if (b >= 2064u) break;
#ifdef PROBE_PREFIX
                if (!(P.flags & 128))
#endif
                {
                if (b >= 16u) { const unsigned g = b - 16u; const int sq = (int)(g >> 8), h = (int)((g >> 5) & 7), c0 = 4 * (int)(g & 31);
                    attn_group(P, lds, (const LAS float*)(lds + TAB_OFF) + h * TAB_LD, sq, h, c0, wave, lane); }
                else attn_unit(P, (const LAS float*)(lds + TAB_OFF) + wave * TAB_LD, lds + wave * 16384, 1024 + (int)b, wave, lane);
                }
                if (tid == 0) { tk[0] = nxt; nxt = __hip_atomic_fetch_add(ctr, 1u, __ATOMIC_RELAXED, __HIP_MEMORY_SCOPE_AGENT); }
            }
        }
    }
    SEAM(3);
    if (IN(5)) { PHASE_IDS;
        for (int pm = blockIdx.x; pm < MP / 256; pm += G) {
            int n4 = 4; asm volatile("" : "+s"(n4));
            const pg8::PanelOrder S{pm, n4};
            { pg8::Gemm g{(const pg8::bf16_t*)(ws + WS_MIX), (const pg8::bf16_t*)(ws + WS_WOUT), MP, 1024, 1024};
              pg8::EpiOutB E{P.x_p, (pg8::bf16_t*)(ws + WS_H1B)};
              pg8::gemm_phase<pg8::EpiOutB, pg8::PanelOrder, PG8_ALIGN, PG8_SP2>(lds, g, S, E); }
            { int k256 = 256; asm volatile("" : "+s"(k256));
              pg8::Gemm g{(const pg8::bf16_t*)(ws + WS_PB), (const pg8::bf16_t*)(ws + WS_WPLE), MP, 1024, k256};
              pg8::EpiE E{(pg8::bf16_t*)(ws + WS_E), (float*)(ws + WS_SSQ)};
              pg8::gemm_phase<pg8::EpiE, pg8::PanelOrder, PG8_ALIGN, PG8_SP2>(lds, g, S, E); }
            asm volatile("s_waitcnt vmcnt(0)" ::: "memory"); __syncthreads();
            if (tid == 0) { __builtin_amdgcn_fence(__ATOMIC_ACQUIRE, "agent"); asm volatile("s_waitcnt vmcnt(0)" ::: "memory"); }
            __syncthreads();
            { pg8::Gemm g{(const pg8::bf16_t*)(ws + WS_H1B), (const pg8::bf16_t*)(ws + WS_WGATE), MP, 1024, 1024};
              pg8::EpiGateB E{P.out + O_Y, (const pg8::bf16_t*)(ws + WS_H1B), (const pg8::bf16_t*)(ws + WS_E), (const float*)(ws + WS_SSQ), P.ple_g};
              pg8::gemm_phase<pg8::EpiGateB, pg8::PanelOrder, PG8_ALIGN, PG8_SP2>(lds, g, S, E); }
        }
        if (wave < 4) for (int tk = blockIdx.x; tk < 256; tk += G) {
            sample_gemm_task<1>((const bf16*)(ws + WS_MIX) + (size_t)MP * 1024, (const bf16*)(ws + WS_WOUT), 1024, tk & 63, 64 * (tk >> 6) + 16 * wave, lane, SEpiOut{P.x_s, (bf16*)(ws + WS_H1B)});
            sample_gemm_task<1>((const bf16*)(ws + WS_PB) + (size_t)MP * 256, (const bf16*)(ws + WS_WPLE), 256, tk & 63, 64 * (tk >> 6) + 16 * wave, lane, SEpiE{(bf16*)(ws + WS_E), (float*)(ws + WS_SSQ)}); }
    }
    SEAM(5);
    if (IN(6)) { PHASE_IDS;
        if (wave < 4) for (int tk = blockIdx.x; tk < 256; tk += G)
            sample_gemm_task<1>((const bf16*)(ws + WS_H1B) + (size_t)MP * 1024, (const bf16*)(ws + WS_WGATE), 1024, tk & 63, 64 * (tk >> 6) + 16 * wave, lane, SEpiGate{P.out + O_Y, (const bf16*)(ws + WS_H1B), (const bf16*)(ws + WS_E), (const float*)(ws + WS_SSQ), P.ple_g});
    }
#undef IN
#undef SEAM
}

extern "C" void kernel_launch(void* const* d_in, const int* in_sizes, int n_in, void* d_out, int out_size, void* d_ws, size_t ws_size, hipStream_t stream) {
    static int grid = 0;
    if (grid == 0) {
        if (n_in != 21 || (size_t)out_size != O_END || ws_size < WS_END) { fprintf(stderr, "kernel_launch: unexpected shapes: n_in %d out %d ws %zu (need %zu); nothing launched\n", n_in, out_size, ws_size, (size_t)WS_END); grid = -1; return; }
        int dev = 0, cus = 0, per_cu = 0;
        if (hipGetDevice(&dev) != hipSuccess || hipDeviceGetAttribute(&cus, hipDeviceAttributeMultiprocessorCount, dev) != hipSuccess) { grid = -1; return; }
        if (hipFuncSetAttribute((const void*)fwd_kernel, hipFuncAttributeMaxDynamicSharedMemorySize, LDS_BYTES) != hipSuccess) { fprintf(stderr, "kernel_launch: hipFuncSetAttribute failed\n"); grid = -1; return; }
        if (hipOccupancyMaxActiveBlocksPerMultiprocessor(&per_cu, (const void*)fwd_kernel, NWAVES * 64, LDS_BYTES) != hipSuccess || per_cu < 1) { fprintf(stderr, "kernel_launch: occupancy query says %d blocks per CU\n", per_cu); }
        (void)hipGetLastError();
        grid = cus;
        if (grid < 128) { fprintf(stderr, "kernel_launch: %d CUs: too few\n", grid); grid = -1; return; }
    }
    if (grid < 0) return;
    if (hipMemsetAsync((char*)d_ws + WS_CTL, 0, CTL_ZERO_BYTES, stream) != hipSuccess) { fprintf(stderr, "kernel_launch: memset failed\n"); return; }
    Params p{};
    const float** pin = (const float**)&p;
    for (int i = 0; i < 21; ++i) pin[i] = (const float*)d_in[i];
    p.out = (float*)d_out; p.ws = (unsigned char*)d_ws;
#if MK_N_LAUNCHES == 1
#ifdef PROBE_PREFIX
    { p.ph_lo = 0; p.ph_hi = PROBE_PREFIX;
#ifdef PROBE_FLAGS
      p.flags = PROBE_FLAGS;
#endif
      void* a0[] = {&p}; (void)hipLaunchCooperativeKernel((const void*)fwd_kernel, dim3(grid), dim3(NWAVES * 64), a0, LDS_BYTES, stream);
      (void)hipMemsetAsync((char*)d_ws + WS_CTL, 0, CTL_ZERO_BYTES, stream); }
#endif
    p.ph_lo = 0; p.ph_hi = N_PHASES; p.flags = 0;
    void* args[] = {&p};
    hipError_t e = hipLaunchCooperativeKernel((const void*)fwd_kernel, dim3(grid), dim3(NWAVES * 64), args, LDS_BYTES, stream);
    if (e != hipSuccess) fprintf(stderr, "kernel_launch: cooperative launch failed: %s (grid %d)\n", hipGetErrorString(e), grid);
#else
    for (int k = 0; k < N_PHASES; ++k) { p.ph_lo = k; p.ph_hi = k + 1;
        hipLaunchKernelGGL(fwd_kernel, dim3(grid), dim3(NWAVES * 64), LDS_BYTES, stream, p);
        const hipError_t le = hipPeekAtLastError(); if (le != hipSuccess) { fprintf(stderr, "kernel_launch: launch %d failed: %s\n", k, hipGetErrorName(le)); break; } }
#endif
}
```

```cpp
#include <hip/hip_runtime.h>
#include <cstdio>
#include <cstdint>
#ifndef MK_N_LAUNCHES
#define MK_N_LAUNCHES 1
#endif
namespace pg8 {
#define PG8_LAS __attribute__((address_space(3)))
typedef unsigned short bf16_t;
typedef short bf16x8 __attribute__((ext_vector_type(8)));
typedef float f32x4 __attribute__((ext_vector_type(4)));
typedef unsigned u32x4 __attribute__((ext_vector_type(4)));
constexpr int BM = 256, BK = 64, HALF = 128, HTB = HALF * BK * 2  , STAGE_BYTES = 8 * HTB, NXCD = 8, WGM = 8;

__host__ __device__ __forceinline__ int lds_byte(int r, int c) { const int st = (r >> 4) * 2 + (c >> 5), rr = r & 15, cc = c & 31, ob = rr * 64 + cc * 2; return st * 1024 + (ob ^ (((ob >> 9) & 1) << 5)); }
__host__ __device__ __forceinline__ void stage_rc(int b, int& R, int& C) { const int st = b / 1024, sb = b % 1024, swz = sb ^ (((sb >> 9) & 1) << 5); R = (st >> 1) * 16 + swz / 64; C = (st & 1) * 32 + (swz % 64) / 2; }
__host__ __device__ __forceinline__ int perm32(int rho) { const int n = rho >> 4, i = rho & 15; return 8 * (i >> 2) + 4 * n + (i & 3); }

struct Unit { int pm, pn; };
struct Gemm { const bf16_t* A; const bf16_t* Bt; int M, N, K; };

struct StaticOrder {
    int nM, nN, nwg, G, c;
    __host__ __device__ void init(int M, int N, int G_, int c_) { nM = M / BM; nN = N / BM; nwg = nM * nN; G = G_; c = c_; }
    __host__ __device__ bool next(int i, Unit& u) const {
        const long L = (long)i * G + c; if (L >= nwg) return false;
        int wgid = (int)L; { const int q = nwg / NXCD, r = nwg % NXCD, xcd = wgid % NXCD, off = wgid / NXCD; wgid = (xcd < r ? xcd * (q + 1) : r * (q + 1) + (xcd - r) * q) + off; }
        const int nig = WGM * nN, gid = wgid / nig, fm = gid * WGM, gsz = (nM - fm) < WGM ? (nM - fm) : WGM;
        u.pm = fm + ((wgid % nig) % gsz); u.pn = (wgid % nig) / gsz; return true;
    }
    __device__ __forceinline__ void a_ready(const Unit&) const {}
    __device__ __forceinline__ void done(const Unit&) const {}
};

typedef float f32x2c __attribute__((ext_vector_type(2))); typedef __bf16 bf16x2c __attribute__((ext_vector_type(2)));
__device__ __forceinline__ unsigned cvt_pk_bf16_v(float lo, float hi) { const f32x2c v = {lo, hi}; const bf16x2c b = __builtin_convertvector(v, bf16x2c); return __builtin_bit_cast(unsigned, b); }
__device__ __forceinline__ unsigned cvt_pk_bf16(float lo, float hi) { unsigned r; asm volatile("v_cvt_pk_bf16_f32 %0, %1, %2" : "=v"(r) : "v"(lo), "v"(hi)); return r; }
typedef unsigned u32x2 __attribute__((ext_vector_type(2)));
struct EpiProj {
    static constexpr bool PERM = true, AFTER_DRAIN = false;
    bf16_t* qkva; bf16_t* qkvb; bf16_t* z;
    __device__ __forceinline__ void operator()(const f32x4 (&acc)[2][2][4][2], const Unit& u_, int wr, int wc, int fr, int fq) const {
        Unit u = u_; asm volatile("" : "+s"(u.pm), "+s"(u.pn));
        bf16_t* base; int ldc, colt;
        if (u.pn < 6) { base = qkva; ldc = 1536; colt = u.pn * 256; }
        else if (u.pn < 12) { base = qkvb; ldc = 1536; colt = (u.pn - 6) * 256; }
        else { base = z; ldc = 1024; colt = (u.pn - 12) * 256; }
        const int row0 = u.pm * BM + wr * 64 + fr; const int col0 = colt + wc * 32 + 8 * fq;
#pragma unroll
        for (int ai = 0; ai < 2; ++ai)
#pragma unroll
            for (int m = 0; m < 4; ++m) { bf16_t* rowp = base + (size_t)(row0 + ai * HALF + m * 16) * ldc + col0;
#pragma unroll
                for (int bj = 0; bj < 2; ++bj) { const f32x4 v0 = acc[ai][bj][m][0], v1 = acc[ai][bj][m][1];
                    u32x4 w; w.x = cvt_pk_bf16(v0[0], v0[1]); w.y = cvt_pk_bf16(v0[2], v0[3]); w.z = cvt_pk_bf16(v1[0], v1[1]); w.w = cvt_pk_bf16(v1[2], v1[3]);
                    *(u32x4*)(rowp + bj * HALF) = w; } }
    }
};
struct EpiE {
    static constexpr bool PERM = true, AFTER_DRAIN = false;
    bf16_t* E; float* ssq;
    __device__ __forceinline__ void operator()(const f32x4 (&acc)[2][2][4][2], const Unit& u_, int wr, int wc, int fr, int fq) const {
        Unit u = u_; asm volatile("" : "+s"(u.pm), "+s"(u.pn));
        const int row0 = u.pm * BM + wr * 64 + fr; const int col0 = u.pn * BM + wc * 32 + 8 * fq;
#pragma unroll
        for (int ai = 0; ai < 2; ++ai)
#pragma unroll
            for (int m = 0; m < 4; ++m) { const int row = row0 + ai * HALF + m * 16; bf16_t* rowp = E + (size_t)row * 1024 + col0; float s = 0.f;
#pragma unroll
                for (int bj = 0; bj < 2; ++bj) { const f32x4 v0 = acc[ai][bj][m][0], v1 = acc[ai][bj][m][1];
                    s += (v0[0] * v0[0] + v0[1] * v0[1]) + (v0[2] * v0[2] + v0[3] * v0[3]) + (v1[0] * v1[0] + v1[1] * v1[1]) + (v1[2] * v1[2] + v1[3] * v1[3]);
                    u32x4 w; w.x = cvt_pk_bf16(v0[0], v0[1]); w.y = cvt_pk_bf16(v0[2], v0[3]); w.z = cvt_pk_bf16(v1[0], v1[1]); w.w = cvt_pk_bf16(v1[2], v1[3]);
                    *(u32x4*)(rowp + bj * HALF) = w; }
                s += __shfl_xor(s, 16); s += __shfl_xor(s, 32);
                if (fq == 0) atomicAdd(ssq + row, s);
                asm volatile("" ::: "memory"); }
    }
};
struct EpiOut {
    static constexpr bool PERM = false, AFTER_DRAIN = false;
    const float* xp; const float* xs; float* y; bf16_t* h1b;
    __device__ __forceinline__ void operator()(const f32x4 (&acc)[2][2][4][2], const Unit& u_, int wr, int wc, int fr, int fq) const {
        Unit u = u_; asm volatile("" : "+s"(u.pm), "+s"(u.pn));
        const int col0 = u.pn * BM + wc * 32 + 4 * fq;
#pragma unroll
        for (int ai = 0; ai < 2; ++ai)
#pragma unroll
            for (int m = 0; m < 4; ++m) { const int row = u.pm * BM + ai * HALF + wr * 64 + m * 16 + fr;
                const float* xrow = (u.pm < 256) ? xp + (size_t)row * 1024 : xs + (size_t)(row - 65536) * 1024;
#pragma unroll
                for (int bj = 0; bj < 2; ++bj)
#pragma unroll
                    for (int n = 0; n < 2; ++n) { const int col = col0 + bj * HALF + n * 16;
                        const f32x4 h = *(const f32x4*)(xrow + col) + acc[ai][bj][m][n];
                        *(f32x4*)(y + (size_t)row * 1024 + col) = h;
                        u32x2 w; w.x = cvt_pk_bf16(h[0], h[1]); w.y = cvt_pk_bf16(h[2], h[3]); *(u32x2*)(h1b + (size_t)row * 1024 + col) = w; }
                if (m & 1) asm volatile("" ::: "memory"); }
    }
};
struct EpiGate {
    static constexpr bool PERM = false, AFTER_DRAIN = false;
    float* y; const bf16_t* E; const float* ssq; const float* pg;
    __device__ __forceinline__ void operator()(const f32x4 (&acc)[2][2][4][2], const Unit& u_, int wr, int wc, int fr, int fq) const {
        Unit u = u_; asm volatile("" : "+s"(u.pm), "+s"(u.pn));
        const int col0 = u.pn * BM + wc * 32 + 4 * fq;
        f32x4 g4[2][2];
#pragma unroll
        for (int bj = 0; bj < 2; ++bj)
#pragma unroll
            for (int n = 0; n < 2; ++n) g4[bj][n] = *(const f32x4*)(pg + col0 + bj * HALF + n * 16);
#pragma unroll
        for (int ai = 0; ai < 2; ++ai)
#pragma unroll
            for (int m = 0; m < 4; ++m) { const int row = u.pm * BM + ai * HALF + wr * 64 + m * 16 + fr;
                const float rstd = __builtin_amdgcn_rsqf(ssq[row] * (1.0f / 1024.0f) + 1e-6f);
#pragma unroll
                for (int bj = 0; bj < 2; ++bj)
#pragma unroll
                    for (int n = 0; n < 2; ++n) { const int col = col0 + bj * HALF + n * 16; const size_t off = (size_t)row * 1024 + col;
                        const f32x4 h = *(const f32x4*)(y + off); const u32x2 eb = *(const u32x2*)(E + off); const f32x4 a = acc[ai][bj][m][n];
                        f32x4 e; e[0] = __uint_as_float(eb.x << 16); e[1] = __uint_as_float(eb.x & 0xffff0000u); e[2] = __uint_as_float(eb.y << 16); e[3] = __uint_as_float(eb.y & 0xffff0000u);
                        f32x4 o;
#pragma unroll
                        for (int i = 0; i < 4; ++i) { const float sg = __builtin_amdgcn_rcpf(1.0f + __expf(-a[i])); o[i] = h[i] + sg * (e[i] * rstd * g4[bj][n][i]); }
                        *(f32x4*)(y + off) = o; }
                if (m & 1) asm volatile("" ::: "memory"); }
    }
};
struct PanelOrder { int pm, n;
    __device__ __forceinline__ bool next(int i, Unit& u) const { if (i >= n) return false; u.pm = pm; u.pn = i; return true; }
    __device__ __forceinline__ void a_ready(const Unit&) const {}
    __device__ __forceinline__ void done(const Unit&) const {} };
struct EpiOutB {
    static constexpr bool PERM = true, AFTER_DRAIN = false;
    const float* xp; bf16_t* h1b;
    __device__ __forceinline__ void operator()(const f32x4 (&acc)[2][2][4][2], const Unit& u_, int wr, int wc, int fr, int fq) const {
        Unit u = u_; asm volatile("" : "+s"(u.pm), "+s"(u.pn));
        const int row0 = u.pm * BM + wr * 64 + fr; const int col0 = u.pn * BM + wc * 32 + 8 * fq;
#pragma unroll
        for (int ai = 0; ai < 2; ++ai)
#pragma unroll
            for (int m = 0; m < 4; ++m) { const size_t off = (size_t)(row0 + ai * HALF + m * 16) * 1024 + col0;
#pragma unroll
                for (int bj = 0; bj < 2; ++bj) { const f32x4 x0 = *(const f32x4*)(xp + off + bj * HALF), x1 = *(const f32x4*)(xp + off + bj * HALF + 4);
                    const f32x4 v0 = acc[ai][bj][m][0] + x0, v1 = acc[ai][bj][m][1] + x1;
                    u32x4 w; w.x = cvt_pk_bf16(v0[0], v0[1]); w.y = cvt_pk_bf16(v0[2], v0[3]); w.z = cvt_pk_bf16(v1[0], v1[1]); w.w = cvt_pk_bf16(v1[2], v1[3]);
                    *(u32x4*)(h1b + off + bj * HALF) = w; }
                if (m & 1) asm volatile("" ::: "memory"); }
    }
};
struct EpiGateB {
    static constexpr bool PERM = true, AFTER_DRAIN = false;
    float* y; const bf16_t* h1b; const bf16_t* E; const float* ssq; const float* pg;
    __device__ __forceinline__ void operator()(const f32x4 (&acc)[2][2][4][2], const Unit& u_, int wr, int wc, int fr, int fq) const {
        Unit u = u_; asm volatile("" : "+s"(u.pm), "+s"(u.pn));
        const int row0 = u.pm * BM + wr * 64 + fr; const int col0 = u.pn * BM + wc * 32 + 8 * fq;
        f32x4 g4[2][2];
#pragma unroll
        for (int bj = 0; bj < 2; ++bj)
#pragma unroll
            for (int n = 0; n < 2; ++n) g4[bj][n] = *(const f32x4*)(pg + col0 + bj * HALF + 4 * n);
#pragma unroll
        for (int ai = 0; ai < 2; ++ai)
#pragma unroll
            for (int m = 0; m < 4; ++m) { const int row = row0 + ai * HALF + m * 16; const size_t off = (size_t)row * 1024 + col0;
                const float rstd = __builtin_amdgcn_rsqf(ssq[row] * (1.0f / 1024.0f) + 1e-6f);
#pragma unroll
                for (int bj = 0; bj < 2; ++bj) { const u32x4 hb = *(const u32x4*)(h1b + off + bj * HALF), eb = *(const u32x4*)(E + off + bj * HALF);
                    const unsigned hw[4] = {hb.x, hb.y, hb.z, hb.w}, ew[4] = {eb.x, eb.y, eb.z, eb.w};
                    f32x4 o[2];
#pragma unroll
                    for (int i = 0; i < 8; ++i) { const float h = (i & 1) ? __uint_as_float(hw[i >> 1] & 0xffff0000u) : __uint_as_float(hw[i >> 1] << 16);
                        const float ee = (i & 1) ? __uint_as_float(ew[i >> 1] & 0xffff0000u) : __uint_as_float(ew[i >> 1] << 16);
                        const float a = acc[ai][bj][m][i >> 2][i & 3]; const float sg = __builtin_amdgcn_rcpf(1.0f + __expf(-a));
                        o[i >> 2][i & 3] = h + sg * (ee * rstd * g4[bj][i >> 2][i & 3]); }
                    *(f32x4*)(y + off + bj * HALF) = o[0]; *(f32x4*)(y + off + bj * HALF + 4) = o[1]; }
                if (m & 1) asm volatile("" ::: "memory"); }
    }
};
template <class Epi, class Sched, bool ALIGN_EPI = false, bool SP2 = false>
__device__ __forceinline__ void gemm_phase(PG8_LAS unsigned char* lds, const Gemm g, const Sched& S, const Epi& E) {
    int tid_l = threadIdx.x; asm volatile("" : "+v"(tid_l));
    const int tid = tid_l, wid = __builtin_amdgcn_readfirstlane(tid >> 6), lane = tid & 63, wr = wid >> 2, wc = wid & 3, fr = lane & 15, fq = lane >> 4;
    const int K = g.K, nt = K / BK;
    unsigned voffA[2], voffB[2];
#pragma unroll
    for (int i = 0; i < 2; ++i) { int R, C; stage_rc(tid * 16 + i * 8192, R, C); const int Rb = Epi::PERM ? ((R & ~31) + perm32(R & 31)) : R;
        voffA[i] = (unsigned)(R * K + C) * 2u; voffB[i] = (unsigned)(Rb * K + C) * 2u; }
    const size_t kstep = (size_t)(BK * 2);
    const size_t hstep = (size_t)HALF * K * 2;
    const size_t tstep = 2 * hstep;
    const unsigned ldsw = (unsigned)wid * 1024u;
    const int aoff = lds_byte(wr * 64 + fr, fq * 8), boff = lds_byte(wc * 32 + fr, fq * 8);
#define PG8_SA(b, h) (((b) * 2 + (h)) * HTB)
#define PG8_SB(b, h) ((4 + (b) * 2 + (h)) * HTB)
#define PG8_STAGE(bufoff, gbase, voff) do { _Pragma("unroll") for (int _i = 0; _i < 2; ++_i) \
        __builtin_amdgcn_global_load_lds((const unsigned*)((const char*)(gbase) + (voff)[_i]), (PG8_LAS unsigned*)(lds + (bufoff) + ldsw + _i * 8192), 16, 0, 0); } while (0)
#define PG8_LDA(dst, b, h) do { _Pragma("unroll") for (int m = 0; m < 4; ++m) _Pragma("unroll") for (int k = 0; k < 2; ++k) dst[m][k] = *(const PG8_LAS bf16x8*)(lds + PG8_SA(b, h) + aoff + m * 2048 + k * 1024); } while (0)
#define PG8_LDB(dst, b, h) do { _Pragma("unroll") for (int n = 0; n < 2; ++n) _Pragma("unroll") for (int k = 0; k < 2; ++k) dst[n][k] = *(const PG8_LAS bf16x8*)(lds + PG8_SB(b, h) + boff + n * 2048 + k * 1024); } while (0)
#define PG8_MMA(ai, bj, At, Bt) do { __builtin_amdgcn_s_setprio(1); _Pragma("unroll") for (int m = 0; m < 4; ++m) _Pragma("unroll") for (int n = 0; n < 2; ++n) _Pragma("unroll") for (int k = 0; k < 2; ++k) \
        acc[ai][bj][m][n] = __builtin_amdgcn_mfma_f32_16x16x32_bf16(Bt[n][k], At[m][k], acc[ai][bj][m][n], 0, 0, 0); __builtin_amdgcn_s_setprio(0); } while (0)
#define PG8_WAIT_V(n) asm volatile("s_waitcnt vmcnt(" #n ")" ::: "memory")
#define PG8_WAIT_L(n) asm volatile("s_waitcnt lgkmcnt(" #n ")" ::: "memory")
#define PG8_BAR __builtin_amdgcn_s_barrier()
#define PG8_SCHED __builtin_amdgcn_sched_barrier(0)
    Unit cur, nxt; int ui = 0;
    if (!S.next(0, cur)) return;
    f32x4 acc[2][2][4][2];
#pragma unroll
    for (int a = 0; a < 2; ++a)
#pragma unroll
        for (int b = 0; b < 2; ++b)
#pragma unroll
            for (int m = 0; m < 4; ++m)
#pragma unroll
                for (int n = 0; n < 2; ++n) acc[a][b][m][n] = (f32x4){0.f, 0.f, 0.f, 0.f};
    bf16x8 At[4][2], B0[2][2], B1[2][2];
    const char* cA = (const char*)g.A + (size_t)cur.pm * tstep; const char* cB = (const char*)g.Bt + (size_t)cur.pn * tstep;
    S.a_ready(cur);
    if constexpr (SP2) {
        PG8_STAGE(PG8_SB(0, 0), cB, voffB); PG8_STAGE(PG8_SB(0, 1), cB + hstep, voffB); PG8_STAGE(PG8_SA(0, 0), cA, voffA); PG8_STAGE(PG8_SA(0, 1), cA + hstep, voffA);
        if (wr == 1) PG8_BAR;
        PG8_WAIT_V(2); PG8_BAR;
        PG8_STAGE(PG8_SB(1, 0), cB + kstep, voffB); PG8_STAGE(PG8_SA(1, 0), cA + kstep, voffA); PG8_STAGE(PG8_SB(1, 1), cB + hstep + kstep, voffB);
        PG8_WAIT_V(6); PG8_BAR;
    } else {
        PG8_STAGE(PG8_SB(0, 0), cB, voffB); PG8_STAGE(PG8_SA(0, 0), cA, voffA); PG8_STAGE(PG8_SB(0, 1), cB + hstep, voffB); PG8_STAGE(PG8_SA(0, 1), cA + hstep, voffA);
        if (wr == 1) PG8_BAR;
        PG8_WAIT_V(4); PG8_BAR;
        PG8_STAGE(PG8_SB(1, 0), cB + kstep, voffB); PG8_STAGE(PG8_SA(1, 0), cA + kstep, voffA); PG8_STAGE(PG8_SB(1, 1), cB + hstep + kstep, voffB);
        PG8_WAIT_V(6); PG8_BAR;
    }
    for (;;) {
        const bool has_next = S.next(ui + 1, nxt);
        const char* nA = has_next ? (const char*)g.A + (size_t)nxt.pm * tstep : cA; const char* nB = has_next ? (const char*)g.Bt + (size_t)nxt.pn * tstep : cB;
        for (int t = 0; t < nt; t += 2) {
            const bool last = (t == nt - 2);
            const char* a1 = cA + (size_t)(t + 1) * kstep;
            const char* a2 = last ? nA : cA + (size_t)(t + 2) * kstep; const char* b2 = last ? nB : cB + (size_t)(t + 2) * kstep;
            const char* a3 = a2 + kstep; const char* b3 = b2 + kstep;
            if (last && has_next) S.a_ready(nxt);
            if constexpr (SP2) {
            PG8_LDB(B0, 0, 0); PG8_LDB(B1, 0, 1); PG8_SCHED; PG8_LDA(At, 0, 0); PG8_STAGE(PG8_SA(1, 1), a1 + hstep, voffA);
            PG8_WAIT_V(8); PG8_WAIT_L(0); PG8_BAR; PG8_MMA(0, 0, At, B0); PG8_MMA(0, 1, At, B1); PG8_BAR; PG8_SCHED;
            PG8_LDA(At, 0, 1); PG8_STAGE(PG8_SB(0, 0), b2, voffB); PG8_STAGE(PG8_SB(0, 1), b2 + hstep, voffB); PG8_STAGE(PG8_SA(0, 0), a2, voffA);
            PG8_WAIT_V(8); PG8_WAIT_L(0); PG8_BAR; PG8_MMA(1, 0, At, B0); PG8_MMA(1, 1, At, B1); PG8_BAR; PG8_SCHED;
            PG8_LDB(B0, 1, 0); PG8_LDB(B1, 1, 1); PG8_SCHED; PG8_LDA(At, 1, 0); PG8_STAGE(PG8_SA(0, 1), a2 + hstep, voffA);
            PG8_WAIT_V(8); PG8_WAIT_L(0); PG8_BAR; PG8_MMA(0, 0, At, B0); PG8_MMA(0, 1, At, B1); PG8_BAR; PG8_SCHED;
            PG8_LDA(At, 1, 1); PG8_STAGE(PG8_SB(1, 0), b3, voffB); PG8_STAGE(PG8_SB(1, 1), b3 + hstep, voffB); PG8_STAGE(PG8_SA(1, 0), a3, voffA);
            PG8_WAIT_V(8); PG8_WAIT_L(0); PG8_BAR; PG8_MMA(1, 0, At, B0); PG8_MMA(1, 1, At, B1); PG8_BAR; PG8_SCHED;
            } else {
            PG8_LDB(B0, 0, 0); PG8_SCHED; PG8_LDA(At, 0, 0); PG8_STAGE(PG8_SA(1, 1), a1 + hstep, voffA);
            PG8_WAIT_L(8); PG8_BAR; PG8_WAIT_L(0); PG8_MMA(0, 0, At, B0); PG8_BAR; PG8_SCHED;
            PG8_LDB(B1, 0, 1); PG8_STAGE(PG8_SB(0, 0), b2, voffB);
            PG8_BAR; PG8_WAIT_L(0); PG8_MMA(0, 1, At, B1); PG8_BAR;
            PG8_LDA(At, 0, 1); PG8_STAGE(PG8_SA(0, 0), a2, voffA);
            PG8_BAR; PG8_WAIT_L(0); PG8_MMA(1, 0, At, B0); PG8_BAR; PG8_SCHED;
            PG8_STAGE(PG8_SB(0, 1), b2 + hstep, voffB);
            PG8_WAIT_V(6); PG8_BAR; PG8_MMA(1, 1, At, B1); PG8_BAR;
            PG8_LDB(B0, 1, 0); PG8_SCHED; PG8_LDA(At, 1, 0); PG8_STAGE(PG8_SA(0, 1), a2 + hstep, voffA);
            PG8_WAIT_L(8); PG8_BAR; PG8_WAIT_L(0); PG8_MMA(0, 0, At, B0); PG8_BAR; PG8_SCHED;
            PG8_LDB(B1, 1, 1); PG8_STAGE(PG8_SB(1, 0), b3, voffB);
            PG8_BAR; PG8_WAIT_L(0); PG8_MMA(0, 1, At, B1); PG8_BAR;
            PG8_LDA(At, 1, 1); PG8_STAGE(PG8_SA(1, 0), a3, voffA);
            PG8_BAR; PG8_WAIT_L(0); PG8_MMA(1, 0, At, B0); PG8_BAR; PG8_SCHED;
            PG8_STAGE(PG8_SB(1, 1), b3 + hstep, voffB);
            PG8_WAIT_V(6); PG8_BAR; PG8_MMA(1, 1, At, B1); PG8_BAR;
            }
        }
        if constexpr (ALIGN_EPI) { if (wr == 0) PG8_BAR; }
        if constexpr (!Epi::AFTER_DRAIN) { E(acc, cur, wr, wc, fr, fq); S.done(cur); }
        if (!has_next) break;
#pragma unroll
        for (int a = 0; a < 2; ++a)
#pragma unroll
            for (int b = 0; b < 2; ++b)
#pragma unroll
                for (int m = 0; m < 4; ++m)
#pragma unroll
                    for (int n = 0; n < 2; ++n) acc[a][b][m][n] = (f32x4){0.f, 0.f, 0.f, 0.f};
        cur = nxt; cA = nA; cB = nB; ++ui;
        if constexpr (ALIGN_EPI) { if (wr == 1) PG8_BAR; }
    }
    PG8_WAIT_V(0);
    if constexpr (!ALIGN_EPI) { if (wr == 0) PG8_BAR; }
    PG8_BAR;
    if constexpr (Epi::AFTER_DRAIN) { E.fused(acc, cur, wr, wc, fr, fq, lds, wid, lane); S.done(cur); }
#undef PG8_SA
#undef PG8_SB
#undef PG8_STAGE
#undef PG8_LDA
#undef PG8_LDB
#undef PG8_MMA
#undef PG8_WAIT_V
#undef PG8_WAIT_L
#undef PG8_BAR
#undef PG8_SCHED
}
}

#ifndef PG8_SP2
#define PG8_SP2 true
#endif
#ifndef PG8_ALIGN
#define PG8_ALIGN true
#endif
constexpr int NWAVES = 8;
constexpr int DM = 1024, TP = 8192, NBP = 8, MP = NBP * TP, NBS = 16, TS = 16, MS = NBS * TS, M = MP + MS;
constexpr int NCU = NBP * 128 + NBS;
constexpr int LDW_IN = 4112;
constexpr size_t O_Y = 0, O_CP = 67371008, O_GP = 67407872, O_KP = 67670016, O_VP = 69767168, O_CS = 71864320, O_GS = 71938048, O_KS = 72462336, O_VS = 72593408, O_END = 72724480;
constexpr size_t MiB = 1u << 20;
constexpr size_t WS_CTL = 0, CTL_ZERO_BYTES = 64 * 1024;
constexpr size_t WS_WIN = 1 * MiB, WS_WOUT = 9 * MiB, WS_WGATE = 11 * MiB, WS_WPLE = 13 * MiB;
constexpr size_t WS_WAB = 13 * MiB + 768 * 1024;
constexpr size_t WS_G = 14 * MiB, WS_BETA = 17 * MiB, WS_GT = 20 * MiB, WS_SSQ = 20 * MiB + 512 * 1024;
constexpr size_t WS_PB = 21 * MiB;
constexpr size_t WS_Z = 54 * MiB;
constexpr size_t WS_QKVA = 183 * MiB;
constexpr size_t WS_QKVB = 376 * MiB;
constexpr size_t WS_OPS = 569 * MiB;
constexpr size_t WS_QF = 894 * MiB;
constexpr size_t WS_KFS = 958 * MiB, WS_VFS = 968 * MiB, WS_QFS = 978 * MiB, WS_OAS = 979 * MiB, WS_END = 980 * MiB;
constexpr size_t WS_MIX = WS_QKVA, WS_H1B = WS_QKVB, WS_XN = WS_OPS, WS_E = WS_OPS;
constexpr size_t YO_KF = 0, YO_VF = 64 * MiB, YO_OA = 128 * MiB;
constexpr int CW_BAR = 4096, CW_ATT = 8192, CW_BP = 12288;
constexpr int OPS_UNIT = 40960, OPS_W = 0, OPS_KT = 8192, OPS_QD = 16384, OPS_QK = 24576, OPS_U = 32768;
constexpr int RING_BYTES = 131072, LDSCTL_OFF = RING_BYTES, MISC_OFF = LDSCTL_OFF + 320, LDS_BYTES = 163840;

#define GAS __attribute__((address_space(1)))
#define LAS __attribute__((address_space(3)))
typedef unsigned short bf16;
typedef unsigned v4u __attribute__((ext_vector_type(4)));
typedef unsigned v2u __attribute__((ext_vector_type(2)));
typedef float f32x4 __attribute__((ext_vector_type(4)));
typedef float f32x16 __attribute__((ext_vector_type(16)));
typedef short bf16x8 __attribute__((ext_vector_type(8)));
typedef GAS unsigned gu32;
#define RLX_AGENT __ATOMIC_RELAXED, __HIP_MEMORY_SCOPE_AGENT
#define LDS_WAIT() asm volatile("s_waitcnt lgkmcnt(0)" ::: "memory")
__device__ __forceinline__ unsigned pk2(float lo, float hi) { return pg8::cvt_pk_bf16_v(lo, hi); }
__device__ __forceinline__ float bflo(unsigned w) { return __uint_as_float(w << 16); }
__device__ __forceinline__ float bfhi(unsigned w) { return __uint_as_float(w & 0xffff0000u); }
__device__ __forceinline__ float bf1(unsigned short b) { return __uint_as_float((unsigned)b << 16); }
__device__ __forceinline__ float siluf(float x) { return x * __builtin_amdgcn_rcpf(1.0f + __expf(-x)); }
__device__ __forceinline__ void glds16_asm(const void* gsrc, LAS unsigned char* lds_dst, bool nt) {
    unsigned keep; const unsigned d = (unsigned)__builtin_amdgcn_readfirstlane((int)(unsigned)(uintptr_t)lds_dst);
    if (nt) asm volatile("s_mov_b32 %0, m0\n\ts_mov_b32 m0, %2\n\ts_nop 0\n\tglobal_load_lds_dwordx4 %1, off nt\n\ts_mov_b32 m0, %0" : "=&s"(keep) : "v"(gsrc), "s"(d) : "memory");
    else    asm volatile("s_mov_b32 %0, m0\n\ts_mov_b32 m0, %2\n\ts_nop 0\n\tglobal_load_lds_dwordx4 %1, off\n\ts_mov_b32 m0, %0" : "=&s"(keep) : "v"(gsrc), "s"(d) : "memory");
}
__device__ __forceinline__ float wave_sum(float v) {
#pragma unroll
    for (int o = 1; o < 64; o <<= 1) v += __shfl_xor(v, o);
    return v;
}
#define XB_TMO      128
#define XB_XCNT(j)  (256  + 64 * (j))
#define XB_XSUB(j)  (1280 + 64 * (j))
#define XB_XGEN(j)  (2304 + 64 * (j))
#define XB_TOP      3328
#define XB_TOPGEN   3392
#define XCD_BAR_WORDS 3456
#define XB_SPIN_CAP (1u << 18)

__device__ __forceinline__ unsigned xb_ld(unsigned* p)              { return __hip_atomic_load(p, __ATOMIC_RELAXED, __HIP_MEMORY_SCOPE_AGENT); }
__device__ __forceinline__ unsigned xb_add(unsigned* p, unsigned v) { return __hip_atomic_fetch_add(p, v, __ATOMIC_RELAXED, __HIP_MEMORY_SCOPE_AGENT); }
__device__ __forceinline__ unsigned xb_xcc_id() { return (unsigned)__builtin_amdgcn_s_getreg((3 << 11) | 20) & 0xFu; }
#define XB_SPIN(cond, bar) do { unsigned _sp = 0; while (cond) { __builtin_amdgcn_s_sleep(1); \
    if ((++_sp & 255u) == 0u) { if (xb_ld(&(bar)[XB_TMO])) break; if (_sp > XB_SPIN_CAP) { atomicAdd(&(bar)[XB_TMO], 1u); break; } } } } while (0)

struct XcdBarrier {
    unsigned* bar; unsigned x;
    volatile LAS unsigned* st;
};

__device__ __forceinline__ XcdBarrier xcd_barrier_post(unsigned* bar, volatile LAS unsigned* st) {
    XcdBarrier b; b.bar = bar; b.x = xb_xcc_id(); b.st = st;
    if (threadIdx.x == 0) (void)xb_add(&bar[XB_XCNT(b.x)], 1u);
    return b;
}
__device__ __forceinline__ void xcd_barrier_complete(unsigned* bar, unsigned x, unsigned& nloc, unsigned& nx) {
    const unsigned G = gridDim.x * gridDim.y * gridDim.z;
    unsigned sum, cnt, mine, sp = 0u;
    for (;;) {
        sum = 0u; cnt = 0u; mine = 0u;
#pragma unroll
        for (unsigned j = 0; j < 16; ++j) { const unsigned c = xb_ld(&bar[XB_XCNT(j)]); sum += c; cnt += (c > 0u) ? 1u : 0u; mine = (j == x) ? c : mine; }
        if (sum == G) break;
        __builtin_amdgcn_s_sleep(1);
        if ((++sp & 255u) == 0u) { if (xb_ld(&bar[XB_TMO])) break; if (sp > XB_SPIN_CAP) { atomicAdd(&bar[XB_TMO], 1u); break; } }
    }
    nloc = mine > 0u ? mine : 1u; nx = cnt > 0u ? cnt : 1u;
}

__device__ __forceinline__ void xcd_barrier(const XcdBarrier& b) {
    asm volatile("s_waitcnt vmcnt(0)" ::: "memory");
    __syncthreads();
    if (threadIdx.x == 0) {
        unsigned* bar = b.bar;
        __builtin_amdgcn_s_waitcnt(0);
        unsigned nloc = b.st[0], nx = b.st[1];
        if (nloc == 0u) { xcd_barrier_complete(bar, b.x, nloc, nx); b.st[0] = nloc; b.st[1] = nx; }
        const unsigned old = xb_add(&bar[XB_XSUB(b.x)], 1u);
        const unsigned gen = old / nloc;
        if (old + 1u == (gen + 1u) * nloc) {
            __builtin_amdgcn_fence(__ATOMIC_RELEASE, "agent");
            asm volatile("s_waitcnt vmcnt(0)" ::: "memory");
            const unsigned og = xb_add(&bar[XB_TOP], 1u);
            const unsigned tg = og / nx;
            if (og + 1u == (tg + 1u) * nx) xb_add(&bar[XB_TOPGEN], 1u);
            else XB_SPIN(xb_ld(&bar[XB_TOPGEN]) == tg, bar);
            __builtin_amdgcn_fence(__ATOMIC_ACQUIRE, "agent");
            xb_add(&bar[XB_XGEN(b.x)], 1u);
            asm volatile("s_waitcnt vmcnt(0)" ::: "memory");
        } else {
            XB_SPIN(xb_ld(&bar[XB_XGEN(b.x)]) == gen, bar);
            __builtin_amdgcn_fence(__ATOMIC_ACQUIRE, "agent");
            asm volatile("s_waitcnt vmcnt(0)" ::: "memory");
        }
    }
    __syncthreads();
}

struct Params {
    const float* x_p; const float* x_s; const float* state_conv; const float* state_gdn; const float* cache_k; const float* cache_v;
    const float* p_p; const float* p_s; const float* ln_g; const float* w_in; const float* conv_w; const float* a_log; const float* dt_bias;
    const float* gdn_g; const float* qn_g; const float* kn_g; const float* rel_bias; const float* w_out; const float* w_ple; const float* ple_g; const float* w_gate;
    float* out; unsigned char* ws; int ph_lo, ph_hi, flags, pad;
};
__device__ __forceinline__ f32x4 mfma16(bf16x8 a, bf16x8 b, f32x4 c) { return __builtin_amdgcn_mfma_f32_16x16x32_bf16(a, b, c, 0, 0, 0); }
__device__ __forceinline__ f32x16 mfma32(bf16x8 a, bf16x8 b, f32x16 c) { return __builtin_amdgcn_mfma_f32_32x32x16_bf16(a, b, c, 0, 0, 0); }
__device__ __forceinline__ bf16x8 pack8(f32x4 a, f32x4 b) { v4u w; w.x = pk2(a[0], a[1]); w.y = pk2(a[2], a[3]); w.z = pk2(b[0], b[1]); w.w = pk2(b[2], b[3]); return __builtin_bit_cast(bf16x8, w); }
__device__ __forceinline__ void unpack8(v4u w, float (&f)[8]) { f[0] = bflo(w.x); f[1] = bfhi(w.x); f[2] = bflo(w.y); f[3] = bfhi(w.y); f[4] = bflo(w.z); f[5] = bfhi(w.z); f[6] = bflo(w.w); f[7] = bfhi(w.w); }
__device__ __forceinline__ v4u packf8(const float (&f)[8]) { v4u w; w.x = pk2(f[0], f[1]); w.y = pk2(f[2], f[3]); w.z = pk2(f[4], f[5]); w.w = pk2(f[6], f[7]); return w; }

__device__ __forceinline__ void p0_tile(const float* W, int ldw, int srccol0, bf16* WT, int K, int dstrow0, int k0, LAS float* scr, int lane) {
#pragma unroll 8
    for (int i = 0; i < 32; ++i) { const int kk = 2 * i + (lane >> 5); scr[kk * 33 + (lane & 31)] = W[(size_t)(k0 + kk) * ldw + srccol0 + (lane & 31)]; }
    LDS_WAIT(); asm volatile("" ::: "memory");
    const int c = lane & 7;
#pragma unroll
    for (int j = 0; j < 4; ++j) { const int n = (lane >> 3) + 8 * j; const LAS float* s = scr + (8 * c) * 33 + n;
        v4u o; o.x = pk2(s[0 * 33], s[1 * 33]); o.y = pk2(s[2 * 33], s[3 * 33]); o.z = pk2(s[4 * 33], s[5 * 33]); o.w = pk2(s[6 * 33], s[7 * 33]);
        *(v4u*)(WT + (size_t)(dstrow0 + n) * K + k0 + 8 * c) = o; }
    LDS_WAIT(); asm volatile("" ::: "memory");
}
__device__ __forceinline__ void phase0(const Params& P, LAS unsigned char* lds, int tid, int lane, int wave, int G) {
    unsigned char* ws = P.ws;
    const int gw = blockIdx.x * NWAVES + wave, NGW = G * NWAVES;
    LAS float* scr = (LAS float*)(lds + wave * 16384);
    bf16* WIN = (bf16*)(ws + WS_WIN); bf16* WOUT = (bf16*)(ws + WS_WOUT); bf16* WGATE = (bf16*)(ws + WS_WGATE); bf16* WPLE = (bf16*)(ws + WS_WPLE);
    constexpr int I_IN = 128 * 16, I_SQ = 32 * 16, I_PLE = 32 * 4, NITEMS = I_IN + 2 * I_SQ + I_PLE;
    for (int it = gw; it < NITEMS; it += NGW) {
        int r = it;
        if (r < I_IN) { const int n0 = 32 * (r & 127), kb = r >> 7; const int src = n0 < 1536 ? n0 : (n0 < 3072 ? n0 + 528 : (n0 < 3584 ? n0 - 1520 : n0 + 16));
            p0_tile(P.w_in, LDW_IN, src, WIN, 1024, n0, 64 * kb, scr, lane); continue; }
        r -= I_IN;
        if (r < I_SQ) { p0_tile(P.w_out, 1024, 32 * (r & 31), WOUT, 1024, 32 * (r & 31), 64 * (r >> 5), scr, lane); continue; }
        r -= I_SQ;
        if (r < I_SQ) { p0_tile(P.w_gate, 1024, 32 * (r & 31), WGATE, 1024, 32 * (r & 31), 64 * (r >> 5), scr, lane); continue; }
        r -= I_SQ;
        p0_tile(P.w_ple, 1024, 32 * (r & 31), WPLE, 256, 32 * (r & 31), 64 * (r >> 5), scr, lane);
    }
    {
        bf16* WAB = (bf16*)(ws + WS_WAB);
        for (int idx = blockIdx.x * 512 + tid; idx < 16384; idx += G * 512) { const int k = idx >> 4, c = idx & 15; WAB[c * 1024 + k] = (bf16)(pk2(P.w_in[(size_t)k * LDW_IN + 1536 + c], 0.f) & 0xffffu); }
    }
    f32x4 lg[4];
#pragma unroll
    for (int j = 0; j < 4; ++j) lg[j] = ((const f32x4*)P.ln_g)[64 * j + lane];
    bf16* XN = (bf16*)(ws + WS_XN);
    f32x4 vnx[4];
    if (gw < M) { const float* xr0 = gw < MP ? P.x_p + (size_t)gw * 1024 : P.x_s + (size_t)(gw - MP) * 1024;
#pragma unroll
        for (int j = 0; j < 4; ++j) vnx[j] = ((const f32x4*)xr0)[64 * j + lane]; }
    for (int m = gw; m < M; m += NGW) {
        f32x4 v[4]; float ss = 0.f;
#pragma unroll
        for (int j = 0; j < 4; ++j) { v[j] = vnx[j]; ss += (v[j][0] * v[j][0] + v[j][1] * v[j][1]) + (v[j][2] * v[j][2] + v[j][3] * v[j][3]); }
        { const int mn = m + NGW; if (mn < M) { const float* xrn = mn < MP ? P.x_p + (size_t)mn * 1024 : P.x_s + (size_t)(mn - MP) * 1024;
#pragma unroll
            for (int j = 0; j < 4; ++j) vnx[j] = ((const f32x4*)xrn)[64 * j + lane]; } }
        ss = wave_sum(ss);
        const float rstd = 1.0f / sqrtf(ss * (1.0f / 1024.0f) + 1e-6f);
        v2u* o8 = (v2u*)(XN + (size_t)m * 1024) + lane;
#pragma unroll
        for (int j = 0; j < 4; ++j) { v[j] = v[j] * rstd * lg[j]; v2u o; o.x = pk2(v[j][0], v[j][1]); o.y = pk2(v[j][2], v[j][3]); o8[64 * j] = o; }
    }
    bf16* PB = (bf16*)(ws + WS_PB);
    for (int m0 = gw; m0 < M; m0 += 4 * NGW) {
        f32x4 pv[4];
#pragma unroll
        for (int k = 0; k < 4; ++k) { const int m = m0 + k * NGW; if (m < M) { const float* prow = m < MP ? P.p_p + (size_t)m * 256 : P.p_s + (size_t)(m - MP) * 256; pv[k] = ((const f32x4*)prow)[lane]; } }
#pragma unroll
        for (int k = 0; k < 4; ++k) { const int m = m0 + k * NGW; if (m < M) { v2u o; o.x = pk2(pv[k][0], pv[k][1]); o.y = pk2(pv[k][2], pv[k][3]); ((v2u*)(PB + (size_t)m * 256))[lane] = o; } }
    }
    float* ssq = (float*)(ws + WS_SSQ);
    for (int i = blockIdx.x * 512 + tid; i < M; i += G * 512) ssq[i] = 0.f;
}
constexpr int QB_OFF = 0, KB_OFF = 9216, VB_OFF = 18432, XQK_OFF = 27648, XW_OFF = 27648, RAW_OFF = 27648  , LM_OFF = 36864, SC_OFF = 54272, DI_OFF = 55552, CW_OFF = 59648, HEAD_LDS = 62720;
struct GdnItem { int cu, s, c, L, m0; bool smp; };
__device__ __forceinline__ GdnItem gdn_item(int item) { GdnItem I; I.cu = item >> 2; I.smp = I.cu >= 1024; I.s = I.smp ? I.cu - 1024 : I.cu >> 7; I.c = I.smp ? 0 : I.cu & 127; I.L = I.smp ? 16 : 64; I.m0 = I.smp ? MP + I.s * 16 : I.s * TP + I.c * 64; return I; }
__device__ __forceinline__ void split4(f32x4 x, f32x4& hi, f32x4& lo) {
#pragma unroll
    for (int i = 0; i < 4; ++i) { const float h = __uint_as_float(pk2(x[i], 0.f) << 16); hi[i] = h; lo[i] = x[i] - h; }
}
__device__ __forceinline__ void gdn_prep_all(const Params& P, LAS unsigned char* lds, int tid, int lane, int wave, int G) {
    const int hh = wave >> 2, tih = tid & 255, wq = wave & 3;
    LAS unsigned char* hb = lds + hh * HEAD_LDS;
    LAS float* sc = (LAS float*)(hb + SC_OFF);
    const float* Gd = (const float*)(P.ws + WS_G); const float* Bd = (const float*)(P.ws + WS_BETA); float* GT = (float*)(P.ws + WS_GT);
    const bf16* QKVA = (const bf16*)(P.ws + WS_QKVA);
    const int t1 = tih >> 2, cg = tih & 3;
    v4u pre[7]; float gpre = 0.f, bpre = 0.f;
    int cw_hp = -1;
    const f32x4 z4 = {0.f, 0.f, 0.f, 0.f};
#define GDN_PREFETCH(itemv) do { const GdnItem J = gdn_item(itemv); const int hJ = 2 * ((itemv) & 3) + hh; \
        _Pragma("unroll") for (int k = 0; k < 7; ++k) { const int q = tih + 256 * k, rr = q / 24, pc = q - rr * 24, r = rr - 3, col = (pc >> 3) * 512 + hJ * 64 + (pc & 7) * 8; \
            v4u w = {0u, 0u, 0u, 0u}; \
            if (q < 1608 && r < J.L) { \
                if (r >= 0 || (!J.smp && J.c > 0)) w = *(const v4u*)(QKVA + (size_t)((long)J.m0 + r) * 1536 + col); \
                else if (J.smp) { const float* sp = P.state_conv + ((size_t)J.s * 3 + rr) * 1536 + col; const f32x4 a = ((const f32x4*)sp)[0], b = ((const f32x4*)sp)[1]; \
                    w.x = pk2(a[0], a[1]); w.y = pk2(a[2], a[3]); w.z = pk2(b[0], b[1]); w.w = pk2(b[2], b[3]); } } \
            pre[k] = w; } \
        if (wq == 0) { gpre = 0.f; bpre = 0.f; if (lane < J.L) { gpre = Gd[(size_t)(J.m0 + lane) * 8 + hJ]; bpre = Bd[(size_t)(J.m0 + lane) * 8 + hJ]; } } } while (0)
    if ((int)blockIdx.x < NCU * 4) GDN_PREFETCH((int)blockIdx.x);
#pragma unroll 1
    for (int item = blockIdx.x; item < NCU * 4; item += G) {
        const GdnItem I = gdn_item(item); const int hp = item & 3, h = 2 * hp + hh;
        if (hp != cw_hp) {
            __syncthreads();
            for (int idx = tih; idx < 768; idx += 256) { const int j = idx / 192, cc = idx % 192; ((LAS float*)(hb + CW_OFF))[idx] = P.conv_w[j * 1536 + (cc >> 6) * 512 + h * 64 + (cc & 63)]; }
            cw_hp = hp;
            __syncthreads();
        }
#pragma unroll
        for (int k = 0; k < 7; ++k) { const int q = tih + 256 * k; if (q < 1608) *(LAS v4u*)(hb + RAW_OFF + q * 16) = pre[k]; }
        __syncthreads();
        if (wq == 0) {
            const int t = lane; float v = gpre;
#pragma unroll
            for (int off = 1; off < 64; off <<= 1) { const float o = __shfl_up(v, off); if (lane >= off) v += o; }
            const float glast = __shfl(v, 63);
            const float eg = expf(v);
            sc[t] = v; sc[64 + t] = bpre; sc[128 + t] = eg; sc[192 + t] = expf(glast - v); sc[256 + t] = bpre * eg;
            if (t == 0) GT[I.cu * 8 + h] = expf(glast);
        }
#ifdef PROBE_PREFIX
        if (!(P.flags & 256))
#endif
        {
            const int t = t1;
#pragma unroll
            for (int p = 0; p < 3; ++p) {
                float acc[16];
#pragma unroll
                for (int i = 0; i < 16; ++i) acc[i] = 0.f;
#pragma unroll
                for (int j = 0; j < 4; ++j) {
                    float rw[16];
                    { const LAS v4u* rp = (const LAS v4u*)(hb + RAW_OFF + (t + j) * 384 + (p * 64 + 16 * cg) * 2);
                      float f0[8], f1[8]; unpack8(rp[0], f0); unpack8(rp[1], f1);
#pragma unroll
                      for (int i = 0; i < 8; ++i) { rw[i] = f0[i]; rw[8 + i] = f1[i]; } }
                    const LAS float* cwj = (const LAS float*)(hb + CW_OFF) + j * 192 + p * 64 + 16 * cg;
#pragma unroll
                    for (int i4 = 0; i4 < 4; ++i4) { const f32x4 w = ((const LAS f32x4*)cwj)[i4];
                        acc[4 * i4] += rw[4 * i4] * w[0]; acc[4 * i4 + 1] += rw[4 * i4 + 1] * w[1]; acc[4 * i4 + 2] += rw[4 * i4 + 2] * w[2]; acc[4 * i4 + 3] += rw[4 * i4 + 3] * w[3]; }
                }
                float ss = 0.f;
#pragma unroll
                for (int i = 0; i < 16; ++i) { acc[i] = siluf(acc[i]); ss += acc[i] * acc[i]; }
                ss += __shfl_xor(ss, 1); ss += __shfl_xor(ss, 2);
                float scale = 1.f;
                if (p == 0) scale = 0.125f * __builtin_amdgcn_rsqf(ss + 1e-6f); else if (p == 1) scale = __builtin_amdgcn_rsqf(ss + 1e-6f);
                if (t >= I.L) scale = 0.f;
                v4u o0, o1;
                o0.x = pk2(acc[0] * scale, acc[1] * scale); o0.y = pk2(acc[2] * scale, acc[3] * scale); o0.z = pk2(acc[4] * scale, acc[5] * scale); o0.w = pk2(acc[6] * scale, acc[7] * scale);
                o1.x = pk2(acc[8] * scale, acc[9] * scale); o1.y = pk2(acc[10] * scale, acc[11] * scale); o1.z = pk2(acc[12] * scale, acc[13] * scale); o1.w = pk2(acc[14] * scale, acc[15] * scale);
                LAS v4u* dst = (LAS v4u*)(hb + p * 9216 + t * 144 + cg * 32);
                dst[0] = o0; dst[1] = o1;
            }
        }
        if (item + G < NCU * 4) GDN_PREFETCH(item + G);
        __syncthreads();
#ifdef PROBE_PREFIX
        if (!(P.flags & 512))
#endif
        {
            const int i = lane & 15, q4 = lane >> 4;
            const LAS unsigned char* kbp = hb + KB_OFF; const LAS unsigned char* qbp = hb + QB_OFF;
#pragma unroll
            for (int k3 = 0; k3 < 3; ++k3) {
                const int idx = wq + 4 * k3;
                if (idx < 10) {
                    const int rho = (idx >= 6) ? 3 : ((idx >= 3) ? 2 : ((idx >= 1) ? 1 : 0)), rp = idx - (rho * (rho + 1)) / 2;
                    bf16x8 ka[2], qa[2], kf[2];
#pragma unroll
                    for (int s2 = 0; s2 < 2; ++s2) { ka[s2] = *(const LAS bf16x8*)(kbp + (16 * rho + i) * 144 + 64 * s2 + 16 * q4); qa[s2] = *(const LAS bf16x8*)(qbp + (16 * rho + i) * 144 + 64 * s2 + 16 * q4);
                        kf[s2] = *(const LAS bf16x8*)(kbp + (16 * rp + i) * 144 + 64 * s2 + 16 * q4); }
                    f32x4 akk = z4, aqk = z4;
#pragma unroll
                    for (int s2 = 0; s2 < 2; ++s2) { akk = mfma16(ka[s2], kf[s2], akk); aqk = mfma16(qa[s2], kf[s2], aqk); }
                    const int tc = 16 * rp + i; const float gcol = sc[tc];
#pragma unroll
                    for (int r = 0; r < 4; ++r) { const int t = 16 * rho + 4 * q4 + r; const float dec = __expf(fminf(sc[t] - gcol, 0.f));
                        const float lv = (tc < t) ? sc[64 + t] * akk[r] * dec : 0.f; const float qv = (tc <= t) ? aqk[r] * dec : 0.f;
                        *(LAS float*)(hb + LM_OFF + t * 272 + tc * 4) = lv;
                        *(LAS unsigned short*)(hb + XQK_OFF + t * 144 + tc * 2) = (unsigned short)(pk2(qv, 0.f) & 0xffffu); }
                }
            }
#pragma unroll
            for (int rp = 1; rp < 4; ++rp) if (rp > wq) {
                const int tc = 16 * rp + i;
#pragma unroll
                for (int r = 0; r < 4; ++r) { const int t = 16 * wq + 4 * q4 + r; *(LAS unsigned short*)(hb + XQK_OFF + t * 144 + tc * 2) = 0; }
            }
        }
        __syncthreads();
        unsigned char* ops = P.ws + WS_OPS + ((size_t)I.cu * 8 + h) * OPS_UNIT;
#ifdef PROBE_PREFIX
        if (!(P.flags & 1024))
#endif
        if (wq == 0) {
            const int b = lane >> 4, c = lane & 15;
            float d[16];
#pragma unroll
            for (int i = 0; i < 16; ++i) {
                float a0 = (i == c) ? 1.f : 0.f;
#pragma unroll
                for (int k = 0; k < (i + 3) / 4; ++k) { const f32x4 l4 = *(const LAS f32x4*)(hb + LM_OFF + (16 * b + i) * 272 + (16 * b + 4 * k) * 4);
#pragma unroll
                    for (int e = 0; e < 4; ++e) if (4 * k + e < i) a0 -= l4[e] * d[4 * k + e]; }
                d[i] = a0;
            }
#pragma unroll
            for (int i = 0; i < 16; ++i) *(LAS float*)(hb + DI_OFF + ((b * 16 + i) * 16 + c) * 4) = d[i];
        } else {
            const int i = lane & 15, q4 = lane >> 4, kind = wq - 1;
#pragma unroll 1
            for (int fr = 0; fr < 8; ++fr) {
                const int rho = fr >> 1, s2 = fr & 1, row = 16 * rho + i;
                v4u o; unsigned char* dst; int frp = fr;
                if (kind == 0) { const v2u lo = *(const LAS v2u*)(hb + XQK_OFF + row * 144 + (32 * s2 + 4 * q4) * 2), hi = *(const LAS v2u*)(hb + XQK_OFF + row * 144 + (32 * s2 + 16 + 4 * q4) * 2);
                    o.x = lo.x; o.y = lo.y; o.z = hi.x; o.w = hi.y; dst = ops + OPS_QK;
                    frp = (fr == 0) ? 0 : (fr == 2) ? 1 : (fr >= 4) ? fr - 2 : (fr == 1 ? 6 : 7); }
                else if (kind == 1) { const v2u lo = *(const LAS v2u*)(hb + QB_OFF + row * 144 + (32 * s2 + 4 * q4) * 2), hi = *(const LAS v2u*)(hb + QB_OFF + row * 144 + (32 * s2 + 16 + 4 * q4) * 2);
                    const float e = sc[128 + row];
                    o.x = pk2(bflo(lo.x) * e, bfhi(lo.x) * e); o.y = pk2(bflo(lo.y) * e, bfhi(lo.y) * e); o.z = pk2(bflo(hi.x) * e, bfhi(hi.x) * e); o.w = pk2(bflo(hi.y) * e, bfhi(hi.y) * e); dst = ops + OPS_QD; }
                else { float vv[8];
#pragma unroll
                    for (int e = 0; e < 8; ++e) { const int t = 32 * s2 + 16 * (e >> 2) + 4 * q4 + (e & 3); vv[e] = bf1(*(const LAS unsigned short*)(hb + KB_OFF + t * 144 + (16 * rho + i) * 2)) * sc[192 + t]; }
                    o = packf8(vv); dst = ops + OPS_KT; }
                *(v4u*)(dst + (frp * 64 + lane) * 16) = o;
            }
        }
        __syncthreads();
#ifdef PROBE_PREFIX
        if (!(P.flags & 2048))
#endif
        {
            const int l15 = lane & 15, q4 = lane >> 4;
            const LAS unsigned char* src = hb + (wq < 2 ? VB_OFF : KB_OFF); const LAS float* scl = sc + (wq < 2 ? 64 : 256);
            f32x4 X[4][2];
#pragma unroll
            for (int b = 0; b < 4; ++b) {
                f32x4 acc[2];
#pragma unroll
                for (int ct = 0; ct < 2; ++ct) { const int col = 32 * (wq & 1) + 16 * ct + l15;
#pragma unroll
                    for (int r = 0; r < 4; ++r) { const int t = 16 * b + 4 * q4 + r; acc[ct][r] = bf1(*(const LAS unsigned short*)(src + t * 144 + col * 2)) * scl[t]; } }
#pragma unroll
                for (int pr = 0; pr < 2; ++pr) {
                    const int m0 = 2 * pr, m1 = 2 * pr + 1;
                    if (m0 < b) {
                        f32x4 l0 = *(const LAS f32x4*)(hb + LM_OFF + (16 * b + l15) * 272 + (16 * m0 + 4 * q4) * 4), l1 = z4;
                        if (m1 < b) l1 = *(const LAS f32x4*)(hb + LM_OFF + (16 * b + l15) * 272 + (16 * m1 + 4 * q4) * 4);
                        const bf16x8 An = pack8(-l0, -l1);
#pragma unroll
                        for (int ct = 0; ct < 2; ++ct) acc[ct] = mfma16(An, pack8(X[m0][ct], (m1 < b) ? X[m1][ct] : z4), acc[ct]);
                    }
                }
                const f32x4 dv = *(const LAS f32x4*)(hb + DI_OFF + ((b * 16 + l15) * 16 + 4 * q4) * 4);
                const bf16x8 Dn = pack8(dv, z4);
#pragma unroll
                for (int ct = 0; ct < 2; ++ct) X[b][ct] = mfma16(Dn, pack8(acc[ct], z4), z4);
            }
            if (wq < 2) {
#pragma unroll
                for (int b = 0; b < 4; ++b)
#pragma unroll
                    for (int ct = 0; ct < 2; ++ct) { const int slice = 2 * (wq & 1) + ct; v2u o; o.x = pk2(X[b][ct][0], X[b][ct][1]); o.y = pk2(X[b][ct][2], X[b][ct][3]);
                        *(v2u*)(ops + OPS_U + ((slice * 4 + b) * 64 + lane) * 8) = o; }
            } else {
#pragma unroll
                for (int b = 0; b < 4; ++b)
#pragma unroll
                    for (int ct = 0; ct < 2; ++ct) { const int col = 32 * (wq & 1) + 16 * ct + l15;
#pragma unroll
                        for (int r = 0; r < 4; ++r) *(LAS unsigned short*)(hb + XW_OFF + (16 * b + 4 * q4 + r) * 144 + col * 2) = (unsigned short)(pk2(X[b][ct][r], 0.f) & 0xffffu); }
            }
        }
        __syncthreads();
        {
            const int i = lane & 15, q4 = lane >> 4;
#pragma unroll
            for (int ff = 0; ff < 2; ++ff) { const int fr = wq * 2 + ff, rho = fr >> 1, s2 = fr & 1, row = 16 * rho + i;
                const v2u lo = *(const LAS v2u*)(hb + XW_OFF + row * 144 + (32 * s2 + 4 * q4) * 2), hi = *(const LAS v2u*)(hb + XW_OFF + row * 144 + (32 * s2 + 16 + 4 * q4) * 2);
                v4u o; o.x = lo.x; o.y = lo.y; o.z = hi.x; o.w = hi.y;
                *(v4u*)(ops + OPS_W + (fr * 64 + lane) * 16) = o; }
        }
        __syncthreads();
    }
#undef GDN_PREFETCH
}
__device__ __forceinline__ void bprep_item(const Params& P, LAS unsigned char* lds, int item, int tid, int lane, int wave) {
    int mode, s, c = 0, pi = 0;
    if (item < 1024) { mode = 0; s = item >> 7; c = item & 127; } else if (item < NCU) { mode = 1; s = item - 1024; } else { mode = 2; s = (item - NCU) >> 3; pi = (item - NCU) & 7; }
    const int tl = tid >> 3, part = tid & 7, kk = part >> 1, hh2 = part & 1, l31 = tl & 31;
    const bf16* QKVB = (const bf16*)(P.ws + WS_QKVB);
    unsigned char* yscr = (unsigned char*)P.out;
    const bool valid = (mode == 1) ? (tl < 16) : true;
    const long m = (mode == 0) ? (long)s * TP + c * 64 + tl : (long)MP + s * 16 + tl;
    size_t kvblk, qblk = 0; unsigned char *kdst, *vdst, *qdst = nullptr;
    if (mode == 0) { kvblk = (size_t)(m >> 5); qblk = kvblk; kdst = yscr + YO_KF; vdst = yscr + YO_VF; qdst = P.ws + WS_QF; }
    else if (mode == 1) { kvblk = (size_t)s * 18 + 16 + (tl >> 5); qblk = (size_t)s * 2 + (tl >> 5); kdst = P.ws + WS_KFS; vdst = P.ws + WS_VFS; qdst = P.ws + WS_QFS; }
    else { kvblk = (size_t)s * 18 + 2 * pi + (tl >> 5); kdst = P.ws + WS_KFS; vdst = P.ws + WS_VFS; }
    const size_t piece = (size_t)kk * 1024 + (size_t)(hh2 * 32 + l31) * 16;
    float qg[8], kg[8];
#pragma unroll
    for (int i = 0; i < 8; ++i) { qg[i] = P.qn_g[8 * part + i]; kg[i] = P.kn_g[8 * part + i]; }
#pragma unroll 1
    for (int hb4 = 0; hb4 < 8; hb4 += 4) {
        v4u wq_[4], wk_[4], wv_[4]; f32x4 ck_[4][2], cv_[4][2];
#pragma unroll
        for (int hi = 0; hi < 4; ++hi) { const int h = hb4 + hi;
            if (mode != 2) { wq_[hi] = wk_[hi] = wv_[hi] = (v4u){0u, 0u, 0u, 0u};
                if (valid) { const bf16* rp = QKVB + (size_t)m * 1536 + h * 64 + 8 * part; wq_[hi] = *(const v4u*)rp; wk_[hi] = *(const v4u*)(rp + 512); wv_[hi] = *(const v4u*)(rp + 1024); } }
            else { const size_t co = (((size_t)s * 512 + 64 * pi + tl) * 8 + h) * 64 + 8 * part;
                ck_[hi][0] = ((const f32x4*)(P.cache_k + co))[0]; ck_[hi][1] = ((const f32x4*)(P.cache_k + co))[1]; cv_[hi][0] = ((const f32x4*)(P.cache_v + co))[0]; cv_[hi][1] = ((const f32x4*)(P.cache_v + co))[1]; } }
#pragma unroll
        for (int hi = 0; hi < 4; ++hi) { const int h = hb4 + hi;
            float f[8];
            if (mode != 2) {
                unpack8(wq_[hi], f); float ss = 0.f;
#pragma unroll
                for (int i = 0; i < 8; ++i) ss += f[i] * f[i];
                ss += __shfl_xor(ss, 1); ss += __shfl_xor(ss, 2); ss += __shfl_xor(ss, 4);
                float rstd = __builtin_amdgcn_rsqf(ss * (1.0f / 64.0f) + 1e-6f);
#pragma unroll
                for (int i = 0; i < 8; ++i) f[i] = f[i] * (rstd * 0.18033688011f) * qg[i];
                *(v4u*)(qdst + (qblk * 8 + h) * 4096 + piece) = packf8(f);
                unpack8(wk_[hi], f); ss = 0.f;
#pragma unroll
                for (int i = 0; i < 8; ++i) ss += f[i] * f[i];
                ss += __shfl_xor(ss, 1); ss += __shfl_xor(ss, 2); ss += __shfl_xor(ss, 4);
                rstd = __builtin_amdgcn_rsqf(ss * (1.0f / 64.0f) + 1e-6f);
#pragma unroll
                for (int i = 0; i < 8; ++i) f[i] = f[i] * rstd * kg[i];
            } else { f[0] = ck_[hi][0][0]; f[1] = ck_[hi][0][1]; f[2] = ck_[hi][0][2]; f[3] = ck_[hi][0][3]; f[4] = ck_[hi][1][0]; f[5] = ck_[hi][1][1]; f[6] = ck_[hi][1][2]; f[7] = ck_[hi][1][3]; }
            *(v4u*)(kdst + (kvblk * 8 + h) * 4096 + piece) = packf8(f);
            {
                float* ko = nullptr;
                if (mode == 0) { const int ts = c * 64 + tl; if (ts >= TP - 512) ko = P.out + O_KP + (((size_t)s * 512 + (ts - (TP - 512))) * 8 + h) * 64 + 8 * part; }
                else if (mode == 1 && valid) ko = P.out + O_KS + (((size_t)s * 16 + tl) * 8 + h) * 64 + 8 * part;
                if (ko) { ((f32x4*)ko)[0] = (f32x4){f[0], f[1], f[2], f[3]}; ((f32x4*)ko)[1] = (f32x4){f[4], f[5], f[6], f[7]}; }
            }
            if (mode != 2) unpack8(wv_[hi], f);
            else { f[0] = cv_[hi][0][0]; f[1] = cv_[hi][0][1]; f[2] = cv_[hi][0][2]; f[3] = cv_[hi][0][3]; f[4] = cv_[hi][1][0]; f[5] = cv_[hi][1][1]; f[6] = cv_[hi][1][2]; f[7] = cv_[hi][1][3]; }
            {
                float* vo = nullptr;
                if (mode == 0) { const int ts = c * 64 + tl; if (ts >= TP - 512) vo = P.out + O_VP + (((size_t)s * 512 + (ts - (TP - 512))) * 8 + h) * 64 + 8 * part; }
                else if (mode == 1 && valid) vo = P.out + O_VS + (((size_t)s * 16 + tl) * 8 + h) * 64 + 8 * part;
                if (vo) { ((f32x4*)vo)[0] = (f32x4){f[0], f[1], f[2], f[3]}; ((f32x4*)vo)[1] = (f32x4){f[4], f[5], f[6], f[7]}; }
            }
            *(LAS v4u*)(lds + (h * 64 + tl) * 144 + part * 16) = packf8(f);
        }
    }
    __syncthreads();
    {
        const size_t blk0 = (mode == 0) ? (size_t)((s * TP + c * 64) >> 5) : (mode == 1 ? (size_t)s * 18 + 16 : (size_t)s * 18 + 2 * pi);
        const int l31v = lane & 31, hhv = lane >> 5;
#pragma unroll 1
        for (int it = 0; it < 8; ++it) {
            const int frag = it * 8 + wave, s2 = frag & 1, dt = (frag >> 1) & 1, h = (frag >> 2) & 7, blkl = frag >> 5;
            float vv[8];
#pragma unroll
            for (int e = 0; e < 8; ++e) { const int key = 32 * blkl + 16 * s2 + 8 * (e >> 2) + 4 * hhv + (e & 3);
                vv[e] = bf1(*(const LAS unsigned short*)(lds + (h * 64 + key) * 144 + (32 * dt + l31v) * 2)); }
            *(v4u*)(vdst + ((blk0 + blkl) * 8 + h) * 4096 + (size_t)(dt * 2 + s2) * 1024 + lane * 16) = packf8(vv);
        }
    }
    __syncthreads();
}
__device__ __forceinline__ void conv_state_out(const Params& P, int tid, int G) {
    const bf16* QKVA = (const bf16*)(P.ws + WS_QKVA);
    for (int idx = blockIdx.x * 512 + tid; idx < 24 * 3 * 1536; idx += G * 512) {
        const int col = idx % 1536, j = (idx / 1536) % 3, sq = idx / (3 * 1536);
        if (sq < 8) P.out[O_CP + ((size_t)sq * 3 + j) * 1536 + col] = bf1(QKVA[((size_t)sq * TP + TP - 3 + j) * 1536 + col]);
        else { const int s = sq - 8; P.out[O_CS + ((size_t)s * 3 + j) * 1536 + col] = bf1(QKVA[((size_t)MP + s * 16 + 13 + j) * 1536 + col]); }
    }
}
__device__ __forceinline__ void scan_chain(const Params& P, bool smp, int s, int h, int sl, int lane) {
    const int l15 = lane & 15, q4 = lane >> 4, e = 16 * sl + l15;
    const int cu0 = smp ? 1024 + s : s * 128, nsteps = smp ? 1 : 128;
    f32x4 S[4];
#pragma unroll
    for (int tau = 0; tau < 4; ++tau)
#pragma unroll
        for (int r = 0; r < 4; ++r) S[tau][r] = smp ? P.state_gdn[(((size_t)s * 8 + h) * 64 + 16 * tau + 4 * q4 + r) * 64 + e] : 0.f;
    const float* GT = (const float*)(P.ws + WS_GT);
    float* OA = (float*)((unsigned char*)P.out + YO_OA); float* OAS = (float*)(P.ws + WS_OAS);
#pragma unroll 1
    for (int n = 0; n < nsteps; ++n) {
        const int cu = cu0 + n; const unsigned char* ops = P.ws + WS_OPS + ((size_t)cu * 8 + h) * OPS_UNIT;
        const float gt = GT[cu * 8 + h];
        const bf16x8* Wf = (const bf16x8*)(ops + OPS_W) + lane; const bf16x8* KT = (const bf16x8*)(ops + OPS_KT) + lane;
        const bf16x8* QD = (const bf16x8*)(ops + OPS_QD) + lane; const bf16x8* QK = (const bf16x8*)(ops + OPS_QK) + lane;
        const v2u* Up = (const v2u*)(ops + OPS_U) + (sl * 4) * 64 + lane;
        bf16x8 Sb[2]; Sb[0] = pack8(S[0], S[1]); Sb[1] = pack8(S[2], S[3]);
        f32x4 vn[4];
#pragma unroll
        for (int tau = 0; tau < 4; ++tau) { f32x4 av = {0.f, 0.f, 0.f, 0.f}; av = mfma16(Wf[(2 * tau) * 64], Sb[0], av); av = mfma16(Wf[(2 * tau + 1) * 64], Sb[1], av);
            const v2u ub = Up[tau * 64]; const f32x4 u = {bflo(ub.x), bfhi(ub.x), bflo(ub.y), bfhi(ub.y)}; vn[tau] = u - av; }
        bf16x8 Vb[2]; Vb[0] = pack8(vn[0], vn[1]); Vb[1] = pack8(vn[2], vn[3]);
        f32x4 ao[4];
#pragma unroll
        for (int tau = 0; tau < 4; ++tau) { f32x4 a = {0.f, 0.f, 0.f, 0.f}; a = mfma16(QD[(2 * tau) * 64], Sb[0], a); a = mfma16(QD[(2 * tau + 1) * 64], Sb[1], a);
            a = mfma16(QK[((tau < 2) ? tau : 2 * tau - 2) * 64], Vb[0], a); if (tau >= 2) a = mfma16(QK[(2 * tau - 1) * 64], Vb[1], a); ao[tau] = a; }
#pragma unroll
        for (int tau = 0; tau < 4; ++tau) { f32x4 a = S[tau] * gt; a = mfma16(KT[(2 * tau) * 64], Vb[0], a); a = mfma16(KT[(2 * tau + 1) * 64], Vb[1], a); S[tau] = a; }
        if (!smp) { float* op = OA + ((size_t)s * TP + n * 64) * 512 + h * 64 + e;
#pragma unroll
            for (int tau = 0; tau < 4; ++tau)
#pragma unroll
                for (int r = 0; r < 4; ++r) op[(size_t)(16 * tau + 4 * q4 + r) * 512] = ao[tau][r];
        } else { float* op = OAS + ((size_t)s * 16) * 512 + h * 64 + e;
#pragma unroll
            for (int r = 0; r < 4; ++r) op[(size_t)(4 * q4 + r) * 512] = ao[0][r]; }
    }
    float* so = P.out + (smp ? O_GS : O_GP) + (((size_t)s * 8 + h) * 64) * 64 + e;
#pragma unroll
    for (int tau = 0; tau < 4; ++tau)
#pragma unroll
        for (int r = 0; r < 4; ++r) so[(size_t)(16 * tau + 4 * q4 + r) * 64] = S[tau][r];
}
constexpr int SR_SLOT = 30720, SR_NS = 4, OT_A = 122880, OT_B = 131584, ZT_OFF = 139776;
__device__ __forceinline__ void scan_prompt_wg(const Params& P, LAS unsigned char* lds, int s, int h, int wave, int lane) {
    constexpr int NST = 128;
    const unsigned char* ops0 = P.ws + WS_OPS + ((size_t)(s * 128) * 8 + h) * OPS_UNIT;
    const size_t step_stride = (size_t)8 * OPS_UNIT;
#define SCAN_BAR() do { asm volatile("" ::: "memory"); __builtin_amdgcn_s_barrier(); asm volatile("" ::: "memory"); } while (0)
    if (wave >= 4) {
        const int lw = wave - 4;
        const int np = (lw < 2) ? 8 : 7, p0 = (lw < 2) ? 8 * lw : 16 + 7 * (lw - 2);
        const unsigned char* src = ops0 + (size_t)p0 * 1024 + lane * 16;
#define SCAN_ISSUE(n, slot) do { const unsigned char* s_ = src + (size_t)(n) * step_stride; LAS unsigned char* d_ = lds + (slot) * SR_SLOT + p0 * 1024; \
        _Pragma("unroll") for (int i_ = 0; i_ < 7; ++i_) glds16_asm(s_ + i_ * 1024, d_ + i_ * 1024, true  ); \
        if (lw < 2) glds16_asm(s_ + 7 * 1024, d_ + 7 * 1024, true); } while (0)
        const int ftid = lw * 64 + lane, ft = ftid >> 2, fp = ftid & 3;
        float gg[16];
#pragma unroll
        for (int i = 0; i < 16; ++i) gg[i] = P.gdn_g[16 * fp + i];
        bf16* Mr = (bf16*)(P.ws + WS_MIX) + ((size_t)s * TP + ft) * 1024 + h * 64 + 16 * fp;
        const unsigned char* zsrc = (const unsigned char*)((const bf16*)(P.ws + WS_Z) + ((size_t)s * TP + 16 * lw + (lane >> 3)) * 1024 + h * 64) + (lane & 7) * 16;
#define SCAN_ZISSUE(n) do { const unsigned char* z_ = zsrc + (size_t)(n) * 64 * 2048; LAS unsigned char* d_ = lds + ZT_OFF + ((n) & 1) * 8192 + (2 * lw) * 1024; \
        glds16_asm(z_, d_, false); glds16_asm(z_ + 8 * 2048, d_ + 1024, false); } while (0)
#pragma unroll
        for (int i = 0; i < 16; ++i) asm volatile("" : "+v"(gg[i]));
        SCAN_ZISSUE(0);
        SCAN_ISSUE(0, 0); SCAN_ISSUE(1, 1); SCAN_ISSUE(2, 2);
        if (lw < 2) asm volatile("s_waitcnt vmcnt(16)" ::: "memory"); else asm volatile("s_waitcnt vmcnt(14)" ::: "memory");
        SCAN_BAR();
        int slot = 3;
#pragma unroll 1
        for (int n = 0; n <= NST; ++n) {
            if (n >= 1) {
                const LAS unsigned char* ot = lds + (((n - 1) & 1) ? OT_B : OT_A) + ft * 128 + fp * 32;
                const LAS unsigned char* zt = lds + ZT_OFF + ((n - 1) & 1) * 8192 + ft * 128 + fp * 32;
                float o[16], zf[16]; { float t0[8], t1[8]; unpack8(*(const LAS v4u*)ot, t0); unpack8(*(const LAS v4u*)(ot + 16), t1);
#pragma unroll
                    for (int i = 0; i < 8; ++i) { o[i] = t0[i]; o[8 + i] = t1[i]; }
                    unpack8(*(const LAS v4u*)zt, t0); unpack8(*(const LAS v4u*)(zt + 16), t1);
#pragma unroll
                    for (int i = 0; i < 8; ++i) { zf[i] = t0[i]; zf[8 + i] = t1[i]; } }
                float ss = 0.f;
#pragma unroll
                for (int i = 0; i < 16; ++i) ss += o[i] * o[i];
                ss += __shfl_xor(ss, 1); ss += __shfl_xor(ss, 2);
                const float rstd = __builtin_amdgcn_rsqf(ss * (1.0f / 64.0f) + 1e-6f);
                float r[16];
#pragma unroll
                for (int i = 0; i < 16; ++i) r[i] = o[i] * rstd * gg[i] * siluf(zf[i]);
                bf16* mp = Mr + (size_t)(n - 1) * 64 * 1024;
                v4u w0, w1; w0.x = pk2(r[0], r[1]); w0.y = pk2(r[2], r[3]); w0.z = pk2(r[4], r[5]); w0.w = pk2(r[6], r[7]); w1.x = pk2(r[8], r[9]); w1.y = pk2(r[10], r[11]); w1.z = pk2(r[12], r[13]); w1.w = pk2(r[14], r[15]);
                *(v4u*)mp = w0; *(v4u*)(mp + 8) = w1;
            }
            if (n < NST) {
                asm volatile("s_waitcnt lgkmcnt(0)" ::: "memory");
                if (n + 1 < NST) SCAN_ZISSUE(n + 1);
                if (n + 3 < NST) SCAN_ISSUE(n + 3, slot);
                if (n >= 2 && n + 3 < NST) { if (lw < 2) asm volatile("s_waitcnt vmcnt(20)" ::: "memory"); else asm volatile("s_waitcnt vmcnt(18)" ::: "memory"); }
                else asm volatile("s_waitcnt vmcnt(0)" ::: "memory");
                slot = (slot == SR_NS - 1) ? 0 : slot + 1;
                SCAN_BAR();
            }
        }
#undef SCAN_ZISSUE
#undef SCAN_ISSUE
    } else {
        const int sl = wave, l15 = lane & 15, q4 = lane >> 4, e = 16 * sl + l15;
        f32x4 S[4];
#pragma unroll
        for (int tau = 0; tau < 4; ++tau) S[tau] = (f32x4){0.f, 0.f, 0.f, 0.f};
        const float* GT = (const float*)(P.ws + WS_GT) + (size_t)(s * 128) * 8 + h;
        const v2u* Ug = (const v2u*)(ops0 + OPS_U) + (sl * 4) * 64 + lane;
        v2u ua[4], ub[4];
#pragma unroll
        for (int tau = 0; tau < 4; ++tau) { ua[tau] = Ug[tau * 64]; ub[tau] = (Ug + step_stride / 8)[tau * 64]; }
        SCAN_BAR();
        int slot = 0;
        float gt = GT[0];
#pragma unroll 1
        for (int n = 0; n < NST; ++n) {
            const LAS unsigned char* ops = lds + slot * SR_SLOT;
            const float gtn = (n + 1 < NST) ? GT[(size_t)(n + 1) * 8] : 0.f;
            v2u uc[4];
#pragma unroll
            for (int tau = 0; tau < 4; ++tau) uc[tau] = (n + 2 < NST) ? (Ug + (size_t)(n + 2) * (step_stride / 8))[tau * 64] : (v2u){0u, 0u};
            const LAS bf16x8* Wf = (const LAS bf16x8*)(ops + OPS_W) + lane; const LAS bf16x8* KT = (const LAS bf16x8*)(ops + OPS_KT) + lane;
            const LAS bf16x8* QD = (const LAS bf16x8*)(ops + OPS_QD) + lane; const LAS bf16x8* QK = (const LAS bf16x8*)(ops + OPS_QK) + lane;
            bf16x8 Sb[2]; Sb[0] = pack8(S[0], S[1]); Sb[1] = pack8(S[2], S[3]);
            f32x4 vn[4];
#pragma unroll
            for (int tau = 0; tau < 4; ++tau) { f32x4 av = {0.f, 0.f, 0.f, 0.f}; av = mfma16(Wf[(2 * tau) * 64], Sb[0], av); av = mfma16(Wf[(2 * tau + 1) * 64], Sb[1], av);
                const f32x4 u = {bflo(ua[tau].x), bfhi(ua[tau].x), bflo(ua[tau].y), bfhi(ua[tau].y)}; vn[tau] = u - av; }
            bf16x8 Vb[2]; Vb[0] = pack8(vn[0], vn[1]); Vb[1] = pack8(vn[2], vn[3]);
            f32x4 ao[4];
#pragma unroll
            for (int tau = 0; tau < 4; ++tau) { f32x4 a = {0.f, 0.f, 0.f, 0.f}; a = mfma16(QD[(2 * tau) * 64], Sb[0], a); a = mfma16(QD[(2 * tau + 1) * 64], Sb[1], a);
                a = mfma16(QK[((tau < 2) ? tau : 2 * tau - 2) * 64], Vb[0], a); if (tau >= 2) a = mfma16(QK[(2 * tau - 1) * 64], Vb[1], a); ao[tau] = a; }
#pragma unroll
            for (int tau = 0; tau < 4; ++tau) { f32x4 a = S[tau] * gt; a = mfma16(KT[(2 * tau) * 64], Vb[0], a); a = mfma16(KT[(2 * tau + 1) * 64], Vb[1], a); S[tau] = a; }
            LAS unsigned char* ot = lds + ((n & 1) ? OT_B : OT_A) + e * 2;
#pragma unroll
            for (int tau = 0; tau < 4; ++tau)
#pragma unroll
                for (int r = 0; r < 4; ++r) *(LAS unsigned short*)(ot + (16 * tau + 4 * q4 + r) * 128) = (unsigned short)(pk2(ao[tau][r], 0.f) & 0xffffu);
            gt = gtn;
#pragma unroll
            for (int tau = 0; tau < 4; ++tau) { ua[tau] = ub[tau]; ub[tau] = uc[tau]; }
            slot = (slot == SR_NS - 1) ? 0 : slot + 1;
            asm volatile("s_waitcnt lgkmcnt(0)" ::: "memory");
            SCAN_BAR();
        }
        float* so = P.out + O_GP + (((size_t)s * 8 + h) * 64) * 64 + e;
#pragma unroll
        for (int tau = 0; tau < 4; ++tau)
#pragma unroll
            for (int r = 0; r < 4; ++r) so[(size_t)(16 * tau + 4 * q4 + r) * 64] = S[tau][r];
    }
#undef SCAN_BAR
}
#ifdef PROBE_PREFIX
#define PROBE_NOEXP (P.flags & 4096)
#define PROBE_NOPV (P.flags & 8192)
#else
#define PROBE_NOEXP 0
#define PROBE_NOPV 0
#endif
constexpr int TAB_LD = 704, TAB_OFF = 131584;
__device__ __forceinline__ float wave_max(float v) {
#pragma unroll
    for (int o = 1; o < 64; o <<= 1) v = fmaxf(v, __shfl_xor(v, o));
    return v;
}
__device__ __forceinline__ void attn_setup(const Params& P, LAS unsigned char* lds, int tid) {
    LAS float* tab = (LAS float*)(lds + TAB_OFF); LAS float* mh = tab + 8 * TAB_LD;
    const int lane = tid & 63, h = tid >> 6;
    const float gq = wave_max(fabsf(P.qn_g[lane])), gk = wave_max(fabsf(P.kn_g[lane]));
    float tb = -1e30f;
    for (int i = lane; i < 257; i += 64) tb = fmaxf(tb, P.rel_bias[h * 257 + i]);
    tb = wave_max(tb);
    if (lane == 0) mh[h] = 8.0f * gq * gk + tb;
    __syncthreads();
    { float tv[11];
#pragma unroll
      for (int k = 0; k < 11; ++k) { const int idx = tid + 512 * k, hh = idx / TAB_LD, r = idx - hh * TAB_LD; tv[k] = P.rel_bias[hh * 257 + (r > 256 ? 256 : r)]; }
#pragma unroll
      for (int k = 0; k < 11; ++k) { const int idx = tid + 512 * k, hh = idx / TAB_LD; tab[idx] = (tv[k] - mh[hh]) * 1.44269504089f; } }
    __syncthreads();
}
__device__ __forceinline__ void attn_unit(const Params& P, const LAS float* tabh, LAS unsigned char* ring, int cu, int h, int lane) {
    const bool smp = cu >= 1024; const int s = smp ? cu - 1024 : cu >> 7; const int c = smp ? 0 : cu & 127;
    const int l31 = lane & 31, hh = lane >> 5;
    const unsigned char* yscr = (const unsigned char*)P.out;
    const unsigned char* qb_ = smp ? P.ws + WS_QFS + ((size_t)(s * 2) * 8 + h) * 4096 : P.ws + WS_QF + ((size_t)(s * 256 + 2 * c) * 8 + h) * 4096;
    const long kblk0 = smp ? (long)s * 18 : (long)s * 256 + 2 * (c - 8);
    const unsigned char* kb_ = (smp ? P.ws + WS_KFS : yscr + YO_KF) + h * 4096;
    const unsigned char* vb_ = (smp ? P.ws + WS_VFS : yscr + YO_VF) + h * 4096;
    bf16x8 qf[2][4];
#pragma unroll
    for (int qb = 0; qb < 2; ++qb)
#pragma unroll
        for (int kk = 0; kk < 4; ++kk) qf[qb][kk] = *(const bf16x8*)(qb_ + (size_t)qb * 32768 + kk * 1024 + lane * 16);
    f32x16 oacc[2][2]; float lsum[2] = {0.f, 0.f};
#pragma unroll
    for (int qb = 0; qb < 2; ++qb)
#pragma unroll
        for (int dt = 0; dt < 2; ++dt)
#pragma unroll
            for (int r = 0; r < 16; ++r) oacc[qb][dt][r] = 0.f;
    const int j_lo = smp ? 0 : (c < 8 ? 2 * (8 - c) : 0), j_hi = smp ? 17 : 18;
    f32x16 cbias;
    { const float bconst = tabh[256];
#pragma unroll
      for (int r = 0; r < 16; ++r) cbias[r] = bconst; }
#define ATT_DMA(jj, sl) do { const unsigned char* kp_ = kb_ + (size_t)(kblk0 + (jj)) * 32768 + lane * 16; const unsigned char* vp_ = vb_ + (size_t)(kblk0 + (jj)) * 32768 + lane * 16; \
        LAS unsigned char* d_ = ring + (sl) * 8192; \
        _Pragma("unroll") for (int kk = 0; kk < 4; ++kk) glds16_asm(kp_ + kk * 1024, d_ + kk * 1024, false); \
        _Pragma("unroll") for (int kk = 0; kk < 4; ++kk) glds16_asm(vp_ + kk * 1024, d_ + 4096 + kk * 1024, false); } while (0)
#define ATT_ZDMA(sl) do { int ln_ = lane; asm volatile("" : "+v"(ln_));     \
        const int tk_ = ln_ >> 3, ch_ = (ln_ & 7) ^ tk_; LAS unsigned char* d_ = ring + (sl) * 8192; \
        _Pragma("unroll") for (int p_ = 0; p_ < 8; ++p_) { const int tok_ = smp ? ((8 * p_ + tk_) & 15) : (8 * p_ + tk_); \
            glds16_asm(zbase + (size_t)tok_ * 2048 + ch_ * 16, d_ + p_ * 1024, false); } } while (0)
#define ATT_BODY(KF, VF, jj) do { const int kt = (jj) >> 1, half = (jj) & 1; \
        _Pragma("unroll") for (int qb = 0; qb < 2; ++qb) { \
            f32x16 sa; \
            if (kt <= 5) { sa = mfma32(KF[0], qf[qb][0], cbias); } \
            else { const LAS float* tp_ = tabh + (512 - 64 * kt - 32 * half + 32 * qb + l31 - 4 * hh + 128 - 27); f32x16 bi; \
                _Pragma("unroll") for (int r = 0; r < 16; ++r) bi[r] = tp_[27 - ((r & 3) + 8 * (r >> 2))]; \
                sa = mfma32(KF[0], qf[qb][0], bi); } \
            _Pragma("unroll") for (int kk = 1; kk < 4; ++kk) sa = mfma32(KF[kk], qf[qb][kk], sa); \
            float p[16]; \
            _Pragma("unroll") for (int r = 0; r < 16; ++r) p[r] = PROBE_NOEXP ? sa[r] : __builtin_amdgcn_exp2f(sa[r]); \
            if (smp && (jj) == 16) { \
                _Pragma("unroll") for (int r = 8; r < 16; ++r) p[r] = 0.f; \
            } \
            { typedef float f32x2_ __attribute__((ext_vector_type(2))); f32x2_ a2 = {p[0], p[1]}, b2 = {p[2], p[3]}; \
              _Pragma("unroll") for (int r = 4; r < 16; r += 4) { a2 += (f32x2_){p[r], p[r + 1]}; b2 += (f32x2_){p[r + 2], p[r + 3]}; } \
              a2 += b2; lsum[qb] += a2.x + a2.y; } \
            v4u w0, w1; w0.x = pk2(p[0], p[1]); w0.y = pk2(p[2], p[3]); w0.z = pk2(p[4], p[5]); w0.w = pk2(p[6], p[7]); w1.x = pk2(p[8], p[9]); w1.y = pk2(p[10], p[11]); w1.z = pk2(p[12], p[13]); w1.w = pk2(p[14], p[15]); \
            const bf16x8 pb0 = __builtin_bit_cast(bf16x8, w0), pb1 = __builtin_bit_cast(bf16x8, w1); \
            if (PROBE_NOPV) { asm volatile("" :: "v"(pb0), "v"(pb1)); } else { \
            _Pragma("unroll") for (int dt = 0; dt < 2; ++dt) { oacc[qb][dt] = mfma32(VF[dt * 2 + 0], pb0, oacc[qb][dt]); oacc[qb][dt] = mfma32(VF[dt * 2 + 1], pb1, oacc[qb][dt]); } } \
        } } while (0)
    int zsl = 0;
    const size_t m0u = smp ? (size_t)MP + s * 16 : (size_t)s * TP + c * 64;
    const unsigned char* zbase = (const unsigned char*)((const bf16*)(P.ws + WS_Z) + m0u * 1024 + 512 + h * 64);
    {
#ifdef PROBE_PREFIX
        const int nb = (P.flags & 16384) ? 2 : (j_hi - j_lo);
#else
        const int nb = j_hi - j_lo;
#endif
        const bool rot = (!smp) && (c >= 8); const int rsh = 8 - (c % 9) + 9;
#define ATT_J(i) (rot ? (2 * ((((i) >> 1) + rsh) % 9) + ((i) & 1)) : (j_lo + (i)))
        bf16x8 kf[4], vf[4];
#ifdef PROBE_PREFIX
        if (!(P.flags & 4)) {
#endif
        ATT_DMA(ATT_J(0), 0);
        if (1 < nb) ATT_DMA(ATT_J(1), 1);
#ifdef PROBE_PREFIX
        }
#endif
#pragma unroll
        for (int qb = 0; qb < 2; ++qb)
#pragma unroll
            for (int kk = 0; kk < 4; ++kk) asm volatile("" : "+v"(qf[qb][kk]));
        int sl = 0;
#pragma unroll 1
        for (int i = 0; i < nb; ++i) {
            if (i + 1 < nb) asm volatile("s_waitcnt vmcnt(8)" ::: "memory"); else asm volatile("s_waitcnt vmcnt(0)" ::: "memory");
            const LAS unsigned char* sp = ring + sl * 8192 + lane * 16;
#pragma unroll
            for (int kk = 0; kk < 4; ++kk) { kf[kk] = *(const LAS bf16x8*)(sp + kk * 1024); vf[kk] = *(const LAS bf16x8*)(sp + 4096 + kk * 1024); }
            asm volatile("s_waitcnt lgkmcnt(0)" ::: "memory");
#ifdef PROBE_PREFIX
            if (i + 2 < nb && !(P.flags & 4)) { const int j2 = ATT_J(i + 2); ATT_DMA(j2, sl); } else if (i + 2 == nb) { ATT_ZDMA(sl); zsl = sl; }
            const int j = ATT_J(i);
            if (!(P.flags & 8)) ATT_BODY(kf, vf, j);
#else
            if (i + 2 < nb) { const int j2 = ATT_J(i + 2); ATT_DMA(j2, sl); } else if (i + 2 == nb) { ATT_ZDMA(sl); zsl = sl; }
            const int j = ATT_J(i);
            ATT_BODY(kf, vf, j);
#endif
            sl ^= 1;
        }
#undef ATT_J
    }
#undef ATT_DMA
#undef ATT_BODY
    {
        const LAS unsigned char* zt = ring + zsl * 8192; LAS unsigned char* ot = ring + (zsl ^ 1) * 8192;
#pragma unroll
        for (int qb = 0; qb < 2; ++qb) {
            const float l = lsum[qb] + __shfl_xor(lsum[qb], 32); const float inv = __builtin_amdgcn_rcpf(l);
            const int tq = 32 * qb + l31;
#ifdef PROBE_PREFIX
            if (!(P.flags & 16))
#endif
#pragma unroll
            for (int dt = 0; dt < 2; ++dt)
#pragma unroll
                for (int rg = 0; rg < 4; ++rg) { const int cc = 4 * dt + rg; const int off = tq * 128 + ((cc ^ (tq & 7)) * 16) + 8 * hh;
                    const v2u zb = *(const LAS v2u*)(zt + off);
                    v2u o; o.x = pk2(oacc[qb][dt][4 * rg] * inv * siluf(bflo(zb.x)), oacc[qb][dt][4 * rg + 1] * inv * siluf(bfhi(zb.x)));
                    o.y = pk2(oacc[qb][dt][4 * rg + 2] * inv * siluf(bflo(zb.y)), oacc[qb][dt][4 * rg + 3] * inv * siluf(bfhi(zb.y)));
                    *(LAS v2u*)(ot + off) = o; }
        }
        bf16* mixb = (bf16*)(P.ws + WS_MIX) + m0u * 1024 + 512 + h * 64;
        const int tk = lane >> 3, ch = lane & 7;
#pragma unroll
        for (int p = 0; p < 8; ++p) { const int tok = 8 * p + tk;
            const v4u w = *(const LAS v4u*)(ot + tok * 128 + ((ch ^ (tok & 7)) * 16));
            if (!smp || tok < 16) *(v4u*)(mixb + (size_t)tok * 1024 + ch * 8) = w; }
        asm volatile("s_waitcnt lgkmcnt(0)" ::: "memory");
    }
}
constexpr int AG_R = 14, AG_D = 6;
__device__ __forceinline__ void attn_group(const Params& P, LAS unsigned char* lds, const LAS float* tabh, int s, int h, int c0, int wave, int lane) {
    const int pi = wave >> 1, qb = wave & 1, c = c0 + pi, l31 = lane & 31, hh = lane >> 5;
    const unsigned char* yscr = (const unsigned char*)P.out;
    const long kblk0 = (long)s * 256 + 2 * (c0 - 8);
    const unsigned char* src = yscr + (wave < 4 ? YO_KF : YO_VF) + (size_t)h * 4096 + (size_t)(wave & 3) * 1024 + lane * 16;
    LAS unsigned char* dstw = lds + (wave < 4 ? 0 : 4096) + (wave & 3) * 1024;
    const int pos_lo = (c0 < 8) ? 2 * (8 - c0) : 0;
    const bool fast = (c0 >= 8);
#ifdef PROBE_PREFIX
#define AG_BAR() do { asm volatile("" ::: "memory"); if (!(P.flags & 524288)) __builtin_amdgcn_s_barrier(); asm volatile("" ::: "memory"); } while (0)
#define AG_NODMA (P.flags & 262144)
#define AG_NOBODY (P.flags & 131072)
#else
#define AG_BAR() do { asm volatile("" ::: "memory"); __builtin_amdgcn_s_barrier(); asm volatile("" ::: "memory"); } while (0)
#define AG_NODMA 0
#define AG_NOBODY 0
#endif
    bf16x8 qf[4];
    { const unsigned char* qp = P.ws + WS_QF + ((size_t)(s * 256 + 2 * c + qb) * 8 + h) * 4096 + lane * 16;
#pragma unroll
      for (int kk = 0; kk < 4; ++kk) qf[kk] = *(const bf16x8*)(qp + kk * 1024);
#pragma unroll
      for (int kk = 0; kk < 4; ++kk) asm volatile("" : "+v"(qf[kk])); }
    f32x16 cbias;
    { const float bconst = tabh[256];
#pragma unroll
      for (int r = 0; r < 16; ++r) cbias[r] = bconst; }
    f32x16 oacc[2]; float lsum = 0.f;
#pragma unroll
    for (int dt = 0; dt < 2; ++dt)
#pragma unroll
        for (int r = 0; r < 16; ++r) oacc[dt][r] = 0.f;
#pragma unroll 1
    for (int p = 0; p <= 6 + AG_D; ++p) if (p >= pos_lo && !AG_NODMA) glds16_asm(src + (size_t)(kblk0 + p) * 32768, dstw + (p % AG_R) * 8192, false);
    if (fast) asm volatile("s_waitcnt vmcnt(6)" ::: "memory"); else asm volatile("s_waitcnt vmcnt(0)" ::: "memory");
    AG_BAR();
#pragma unroll 1
    for (int t = 0; t < 18; ++t) {
        { const int pn = t + 7 + AG_D; if (pn < 24 && pn >= pos_lo && !AG_NODMA) glds16_asm(src + (size_t)(kblk0 + pn) * 32768, dstw + (pn % AG_R) * 8192, false); }
        const int p = 2 * pi + t;
        if (p >= pos_lo && !AG_NOBODY) {
            const LAS unsigned char* sp = lds + (p % AG_R) * 8192 + lane * 16;
            bf16x8 kf[4], vf[4];
#pragma unroll
            for (int kk = 0; kk < 4; ++kk) { kf[kk] = *(const LAS bf16x8*)(sp + kk * 1024); vf[kk] = *(const LAS bf16x8*)(sp + 4096 + kk * 1024); }
            const int kt = t >> 1, half = t & 1;
            f32x16 sa;
            if (kt <= 5) sa = mfma32(kf[0], qf[0], cbias);
            else { const LAS float* tp_ = tabh + (512 - 64 * kt - 32 * half + 32 * qb + l31 - 4 * hh + 128 - 27); f32x16 bi;
#pragma unroll
                for (int r = 0; r < 16; ++r) bi[r] = tp_[27 - ((r & 3) + 8 * (r >> 2))];
                sa = mfma32(kf[0], qf[0], bi); }
#pragma unroll
            for (int kk = 1; kk < 4; ++kk) sa = mfma32(kf[kk], qf[kk], sa);
            float pr[16];
#pragma unroll
            for (int r = 0; r < 16; ++r) pr[r] = __builtin_amdgcn_exp2f(sa[r]);
            { typedef float f32x2_ __attribute__((ext_vector_type(2))); f32x2_ a2 = {pr[0], pr[1]}, b2 = {pr[2], pr[3]};
#pragma unroll
              for (int r = 4; r < 16; r += 4) { a2 += (f32x2_){pr[r], pr[r + 1]}; b2 += (f32x2_){pr[r + 2], pr[r + 3]}; }
              a2 += b2; lsum += a2.x + a2.y; }
            v4u w0, w1; w0.x = pk2(pr[0], pr[1]); w0.y = pk2(pr[2], pr[3]); w0.z = pk2(pr[4], pr[5]); w0.w = pk2(pr[6], pr[7]); w1.x = pk2(pr[8], pr[9]); w1.y = pk2(pr[10], pr[11]); w1.z = pk2(pr[12], pr[13]); w1.w = pk2(pr[14], pr[15]);
            const bf16x8 pb0 = __builtin_bit_cast(bf16x8, w0), pb1 = __builtin_bit_cast(bf16x8, w1);
#pragma unroll
            for (int dt = 0; dt < 2; ++dt) { oacc[dt] = mfma32(vf[dt * 2 + 0], pb0, oacc[dt]); oacc[dt] = mfma32(vf[dt * 2 + 1], pb1, oacc[dt]); }
        }
        asm volatile("s_waitcnt lgkmcnt(0)" ::: "memory");
        if (fast && t + 7 + AG_D < 24) asm volatile("s_waitcnt vmcnt(6)" ::: "memory"); else asm volatile("s_waitcnt vmcnt(0)" ::: "memory");
        AG_BAR();
    }
#undef AG_BAR
    {
        const float l = lsum + __shfl_xor(lsum, 32); const float inv = __builtin_amdgcn_rcpf(l);
        const size_t mrow = (size_t)s * TP + c * 64 + 32 * qb + l31;
        const bf16* Z = (const bf16*)(P.ws + WS_Z); bf16* MIX = (bf16*)(P.ws + WS_MIX);
#pragma unroll
        for (int dt = 0; dt < 2; ++dt)
#pragma unroll
            for (int rg = 0; rg < 4; ++rg) { const int d0 = 32 * dt + 8 * rg + 4 * hh; const size_t off = mrow * 1024 + 512 + h * 64 + d0;
                const v2u zb = *(const v2u*)(Z + off);
                v2u o; o.x = pk2(oacc[dt][4 * rg] * inv * siluf(bflo(zb.x)), oacc[dt][4 * rg + 1] * inv * siluf(bfhi(zb.x))); o.y = pk2(oacc[dt][4 * rg + 2] * inv * siluf(bflo(zb.y)), oacc[dt][4 * rg + 3] * inv * siluf(bfhi(zb.y)));
                *(v2u*)(MIX + off) = o; }
    }
}
template <int RT, class F>
__device__ __forceinline__ void sample_gemm_task(const bf16* A, const bf16* Bt, int K, int ct, int row0, int lane, F f) {
    const int l15 = lane & 15, q4 = lane >> 4;
    f32x4 acc[RT];
#pragma unroll
    for (int rt = 0; rt < RT; ++rt) acc[rt] = (f32x4){0.f, 0.f, 0.f, 0.f};
    const bf16* bp = Bt + (size_t)(16 * ct + l15) * K + 8 * q4;
    const bf16* ap = A + (size_t)(row0 + l15) * K + 8 * q4;
#pragma unroll 4
    for (int ks = 0; ks < K / 32; ++ks) { const bf16x8 b = *(const bf16x8*)(bp + 32 * ks);
#pragma unroll
        for (int rt = 0; rt < RT; ++rt) { const bf16x8 a = *(const bf16x8*)(ap + (size_t)(16 * rt) * K + 32 * ks); acc[rt] = mfma16(a, b, acc[rt]); } }
#pragma unroll
    for (int rt = 0; rt < RT; ++rt)
#pragma unroll
        for (int r = 0; r < 4; ++r) f(row0 + 16 * rt + 4 * q4 + r, 16 * ct + l15, acc[rt][r]);
}
struct SEpiProj { bf16* qkva; bf16* qkvb; bf16* z;
    __device__ __forceinline__ void operator()(int row, int n, float v) const { const size_t m = (size_t)MP + row; const bf16 b = (bf16)(pk2(v, 0.f) & 0xffffu);
        if (n < 1536) qkva[m * 1536 + n] = b; else if (n < 3072) qkvb[m * 1536 + (n - 1536)] = b; else z[m * 1024 + (n - 3072)] = b; } };
struct SEpiOut { const float* xs; bf16* h1b;
    __device__ __forceinline__ void operator()(int row, int n, float v) const { const size_t m = (size_t)MP + row; const float h = xs[(size_t)row * 1024 + n] + v; h1b[m * 1024 + n] = (bf16)(pk2(h, 0.f) & 0xffffu); } };
struct SEpiE { bf16* E; float* ssq;
    __device__ __forceinline__ void operator()(int row, int n, float v) const { const size_t m = (size_t)MP + row; E[m * 1024 + n] = (bf16)(pk2(v, 0.f) & 0xffffu);
        float s = v * v; s += __shfl_xor(s, 1); s += __shfl_xor(s, 2); s += __shfl_xor(s, 4); s += __shfl_xor(s, 8);
        if ((threadIdx.x & 15) == 0) atomicAdd(ssq + m, s); } };
struct SEpiGate { float* y; const bf16* h1b; const bf16* E; const float* ssq; const float* pg;
    __device__ __forceinline__ void operator()(int row, int n, float v) const { const size_t m = (size_t)MP + row; const float rstd = 1.0f / sqrtf(ssq[m] * (1.0f / 1024.0f) + 1e-6f);
        const float sg = __builtin_amdgcn_rcpf(1.0f + __expf(-v)); y[m * 1024 + n] = bf1(h1b[m * 1024 + n]) + sg * (bf1(E[m * 1024 + n]) * rstd * pg[n]); } };
__device__ __forceinline__ void gate_tile(const Params& P, int tile, int lane) {
    const int l15 = lane & 15, q4 = lane >> 4;
    const bf16* ap = (const bf16*)(P.ws + WS_XN) + (size_t)(16 * tile + l15) * 1024 + 8 * q4;
    const bf16* bp = (const bf16*)(P.ws + WS_WAB) + (size_t)l15 * 1024 + 8 * q4;
    f32x4 acc = {0.f, 0.f, 0.f, 0.f};
#pragma unroll 8
    for (int ks = 0; ks < 32; ++ks) acc = mfma16(*(const bf16x8*)(ap + 32 * ks), *(const bf16x8*)(bp + 32 * ks), acc);
    float* Gd = (float*)(P.ws + WS_G); float* Bd = (float*)(P.ws + WS_BETA);
    const int c = l15;
    const float al = (c < 8) ? -expf(P.a_log[c]) : 0.f, db = (c < 8) ? P.dt_bias[c] : 0.f;
#pragma unroll
    for (int r = 0; r < 4; ++r) { const size_t mrow = (size_t)16 * tile + 4 * q4 + r; const float v = acc[r];
        if (c < 8) { const float xx = v + db; const float sp = xx > 20.f ? xx : log1pf(expf(xx)); Gd[mrow * 8 + c] = al * sp; }
        else Bd[mrow * 8 + (c - 8)] = 1.0f / (1.0f + expf(-v)); }
}
__device__ __forceinline__ void phase4(const Params& P, int lane, int wave, int G) {
    const int gw = blockIdx.x * NWAVES + wave, NGW = G * NWAVES;
    const float* OA = (const float*)((const unsigned char*)P.out + YO_OA); const float* OAS = (const float*)(P.ws + WS_OAS);
    const bf16* Z = (const bf16*)(P.ws + WS_Z); bf16* MIX = (bf16*)(P.ws + WS_MIX);
    float gg[8];
#pragma unroll
    for (int i = 0; i < 8; ++i) gg[i] = P.gdn_g[(8 * lane + i) & 63];
    for (int m = gw; m < M; m += NGW) {
        const float* orow = m < MP ? OA + (size_t)m * 512 : OAS + (size_t)(m - MP) * 512;
        const f32x4 a = ((const f32x4*)orow)[2 * lane], b = ((const f32x4*)orow)[2 * lane + 1];
        float f[8] = {a[0], a[1], a[2], a[3], b[0], b[1], b[2], b[3]};
        float ss = 0.f;
#pragma unroll
        for (int i = 0; i < 8; ++i) ss += f[i] * f[i];
        ss += __shfl_xor(ss, 1); ss += __shfl_xor(ss, 2); ss += __shfl_xor(ss, 4);
        const float rstd = __builtin_amdgcn_rsqf(ss * (1.0f / 64.0f) + 1e-6f);
        const v4u zw = *(const v4u*)(Z + (size_t)m * 1024 + 8 * lane); float z[8]; unpack8(zw, z);
#pragma unroll
        for (int i = 0; i < 8; ++i) f[i] = f[i] * rstd * gg[i] * siluf(z[i]);
        *(v4u*)(MIX + (size_t)m * 1024 + 8 * lane) = packf8(f);
    }
}
constexpr int N_PHASES = 7;
__global__ void __launch_bounds__(NWAVES * 64, 2) fwd_kernel(Params P) {
    extern __shared__ __attribute__((aligned(16))) unsigned char lds_raw[];
    LAS unsigned char* lds = (LAS unsigned char*)lds_raw;
    volatile LAS unsigned* MISC = (volatile LAS unsigned*)(lds + MISC_OFF);
    const int G = gridDim.x;
#define PHASE_IDS int tid = threadIdx.x; asm volatile("" : "+v"(tid)); const int lane = tid & 63, wave = __builtin_amdgcn_readfirstlane(tid >> 6); (void)lane; (void)wave
    { PHASE_IDS;
    for (int u = tid; u < (LDS_BYTES - LDSCTL_OFF) / 4; u += NWAVES * 64) ((LAS unsigned*)(lds + LDSCTL_OFF))[u] = 0u; }
    __syncthreads();
    unsigned char* ws = P.ws;
    const int lo = P.ph_lo, hi = P.ph_hi;
    const bool multi = (hi - lo) > 1;
    XcdBarrier bar; bar.bar = (unsigned*)(ws + WS_CTL) + CW_BAR; bar.x = 0; bar.st = nullptr;
    if (multi) bar = xcd_barrier_post((unsigned*)(ws + WS_CTL) + CW_BAR, MISC + 8);
#ifndef PROBE_REP
#define PROBE_REP -1
#endif
#define IN(k) (lo <= (k) && (k) < hi)
#define REP(k) _Pragma("unroll") for (int rep_ = 0; rep_ < ((PROBE_REP == (k)) ? 2 : 1); ++rep_)
#define SEAM(k) do { if (IN(k) && IN((k) + 1)) xcd_barrier(bar); } while (0)
    if (IN(0)) REP(0) { PHASE_IDS; phase0(P, lds, tid, lane, wave, G); __syncthreads(); }
    SEAM(0);
    if (IN(1)) REP(1) { PHASE_IDS;
        pg8::Gemm g{(const pg8::bf16_t*)(ws + WS_XN), (const pg8::bf16_t*)(ws + WS_WIN), MP, 4096, 1024}; pg8::StaticOrder S;
#ifdef PROBE_PREFIX
        S.init((P.flags & 1048576) ? MP / 4 : MP, 4096, G, (int)blockIdx.x);
#else
        S.init(MP, 4096, G, (int)blockIdx.x);
#endif
        pg8::EpiProj E{(pg8::bf16_t*)(ws + WS_QKVA), (pg8::bf16_t*)(ws + WS_QKVB), (pg8::bf16_t*)(ws + WS_Z)};
        pg8::gemm_phase<pg8::EpiProj, pg8::StaticOrder, PG8_ALIGN, PG8_SP2>(lds, g, S, E);
        for (int tl = (int)blockIdx.x * NWAVES + wave; tl < M / 16; tl += G * NWAVES) gate_tile(P, tl, lane);
        for (int ct = blockIdx.x; ct < 256; ct += G)
            sample_gemm_task<2>((const bf16*)(ws + WS_XN) + (size_t)MP * 1024, (const bf16*)(ws + WS_WIN), 1024, ct, 32 * wave, lane, SEpiProj{(bf16*)(ws + WS_QKVA), (bf16*)(ws + WS_QKVB), (bf16*)(ws + WS_Z)});
    }
    SEAM(1);
    if (IN(2)) REP(2) { PHASE_IDS;
        if (!(P.flags & 32)) REP(20) { gdn_prep_all(P, lds, tid, lane, wave, G);
        __syncthreads(); }
        if (!(P.flags & 64)) REP(21) for (int it = (G - 1 - (int)blockIdx.x); it < NCU + NBS * 8; it += G) bprep_item(P, lds, it, tid, lane, wave);
        conv_state_out(P, tid, G);
    }
    SEAM(2);
    if (IN(3)) REP(3) { PHASE_IDS;
        const int NSC = 64;
        if ((int)blockIdx.x < NSC && !(P.flags & 1)) {
            { const int pr = (int)blockIdx.x * 2 + (wave >> 2); scan_chain(P, true, pr >> 3, pr & 7, wave & 3, lane); }
            asm volatile("s_waitcnt vmcnt(0)" ::: "memory"); __syncthreads();
            {
                const int pr = (int)blockIdx.x * 2 + (tid >> 8), sp = pr >> 3, hp_ = pr & 7, t = (tid >> 4) & 15, part = tid & 15;
                const size_t row = (size_t)sp * 16 + t;
                const f32x4 o4 = *(const f32x4*)((const float*)(ws + WS_OAS) + row * 512 + hp_ * 64 + 4 * part);
                float ss = (o4[0] * o4[0] + o4[1] * o4[1]) + (o4[2] * o4[2] + o4[3] * o4[3]);
                ss += __shfl_xor(ss, 1); ss += __shfl_xor(ss, 2); ss += __shfl_xor(ss, 4); ss += __shfl_xor(ss, 8);
                const float rstd = __builtin_amdgcn_rsqf(ss * (1.0f / 64.0f) + 1e-6f);
                const size_t mo = ((size_t)MP + row) * 1024 + hp_ * 64 + 4 * part;
                const v2u zb = *(const v2u*)((const bf16*)(ws + WS_Z) + mo);
                const f32x4 g4 = *(const f32x4*)(P.gdn_g + 4 * part);
                v2u o; o.x = pk2(o4[0] * rstd * g4[0] * siluf(bflo(zb.x)), o4[1] * rstd * g4[1] * siluf(bfhi(zb.x))); o.y = pk2(o4[2] * rstd * g4[2] * siluf(bflo(zb.y)), o4[3] * rstd * g4[3] * siluf(bfhi(zb.y)));
                *(v2u*)((bf16*)(ws + WS_MIX) + mo) = o;
            }
            __syncthreads();
            REP(30) { scan_prompt_wg(P, lds, (int)blockIdx.x >> 3, (int)blockIdx.x & 7, wave, lane); __syncthreads(); }
            __syncthreads();
        }
        attn_setup(P, lds, tid);
#ifdef PROBE_PREFIX
        if (P.flags & 32768) {
            f32x4 acc = {0.f, 0.f, 0.f, 0.f}; bf16x8 a = {1, 2, 3, 4, 5, 6, 7, 8}, b = {1, 1, 1, 1, 1, 1, 1, 1};
            for (int i = 0; i < 20000; ++i) acc = mfma16(a, b, acc);
            if (acc[0] == 123.456f) ((float*)(ws + WS_OAS))[tid] = acc[0];
        }
        if (P.flags & 65536) {
            float x = (float)tid * 1e-9f;
            for (int i = 0; i < 200000; ++i) x = __builtin_fmaf(x, 0.999f, 1e-7f);
            if (x == 123.456f) ((float*)(ws + WS_OAS))[tid] = x;
        }
#endif
        if (!(P.flags & 2)) REP(31) {
            unsigned* ctr = (unsigned*)(ws + WS_CTL) + CW_ATT + (rep_ ? 64 * 16 : 0);
            volatile LAS unsigned* tk = (volatile LAS unsigned*)(lds + TAB_OFF + 8 * TAB_LD * 4 + 64);
            unsigned nxt = 0;
            if (tid == 0) { tk[0] = __hip_atomic_fetch_add(ctr, 1u, __ATOMIC_RELAXED, __HIP_MEMORY_SCOPE_AGENT); nxt = __hip_atomic_fetch_add(ctr, 1u, __ATOMIC_RELAXED, __HIP_MEMORY_SCOPE_AGENT); }
            for (;;) {
                __syncthreads();
                const unsigned b = tk[0];
                __syncthreads();
                if (b >= 2064u) break;
#ifdef PROBE_PREFIX
                if (!(P.flags & 128))
#endif
                {
                if (b >= 16u) { const unsigned g = b - 16u; const int sq = (int)(g >> 8), h = (int)((g >> 5) & 7), c0 = 4 * (int)(g & 31);
                    attn_group(P, lds, (const LAS float*)(lds + TAB_OFF) + h * TAB_LD, sq, h, c0, wave, lane); }
                else attn_unit(P, (const LAS float*)(lds + TAB_OFF) + wave * TAB_LD, lds + wave * 16384, 1024 + (int)b, wave, lane);
                }
                if (tid == 0) { tk[0] = nxt; nxt = __hip_atomic_fetch_add(ctr, 1u, __ATOMIC_RELAXED, __HIP_MEMORY_SCOPE_AGENT); }
            }
        }
    }
    SEAM(3);
    if (IN(5)) { PHASE_IDS;
        for (int pm = blockIdx.x; pm < MP / 256; pm += G) {
            int n4 = 4; asm volatile("" : "+s"(n4));
            const pg8::PanelOrder S{pm, n4};
            { pg8::Gemm g{(const pg8::bf16_t*)(ws + WS_MIX), (const pg8::bf16_t*)(ws + WS_WOUT), MP, 1024, 1024};
              pg8::EpiOutB E{P.x_p, (pg8::bf16_t*)(ws + WS_H1B)};
              pg8::gemm_phase<pg8::EpiOutB, pg8::PanelOrder, PG8_ALIGN, PG8_SP2>(lds, g, S, E); }
            { int k256 = 256; asm volatile("" : "+s"(k256));
              pg8::Gemm g{(const pg8::bf16_t*)(ws + WS_PB), (const pg8::bf16_t*)(ws + WS_WPLE), MP, 1024, k256};
              pg8::EpiE E{(pg8::bf16_t*)(ws + WS_E), (float*)(ws + WS_SSQ)};
              pg8::gemm_phase<pg8::EpiE, pg8::PanelOrder, PG8_ALIGN, PG8_SP2>(lds, g, S, E); }
            asm volatile("s_waitcnt vmcnt(0)" ::: "memory"); __syncthreads();
            if (tid == 0) { __builtin_amdgcn_fence(__ATOMIC_ACQUIRE, "agent"); asm volatile("s_waitcnt vmcnt(0)" ::: "memory"); }
            __syncthreads();
            { pg8::Gemm g{(const pg8::bf16_t*)(ws + WS_H1B), (const pg8::bf16_t*)(ws + WS_WGATE), MP, 1024, 1024};
              pg8::EpiGateB E{P.out + O_Y, (const pg8::bf16_t*)(ws + WS_H1B), (const pg8::bf16_t*)(ws + WS_E), (const float*)(ws + WS_SSQ), P.ple_g};
              pg8::gemm_phase<pg8::EpiGateB, pg8::PanelOrder, PG8_ALIGN, PG8_SP2>(lds, g, S, E); }
        }
        if (wave < 4) for (int tk = blockIdx.x; tk < 256; tk += G) {
            sample_gemm_task<1>((const bf16*)(ws + WS_MIX) + (size_t)MP * 1024, (const bf16*)(ws + WS_WOUT), 1024, tk & 63, 64 * (tk >> 6) + 16 * wave, lane, SEpiOut{P.x_s, (bf16*)(ws + WS_H1B)});
            sample_gemm_task<1>((const bf16*)(ws + WS_PB) + (size_t)MP * 256, (const bf16*)(ws + WS_WPLE), 256, tk & 63, 64 * (tk >> 6) + 16 * wave, lane, SEpiE{(bf16*)(ws + WS_E), (float*)(ws + WS_SSQ)}); }
    }
    SEAM(5);
    if (IN(6)) { PHASE_IDS;
        if (wave < 4) for (int tk = blockIdx.x; tk < 256; tk += G)
            sample_gemm_task<1>((const bf16*)(ws + WS_H1B) + (size_t)MP * 1024, (const bf16*)(ws + WS_WGATE), 1024, tk & 63, 64 * (tk >> 6) + 16 * wave, lane, SEpiGate{P.out + O_Y, (const bf16*)(ws + WS_H1B), (const bf16*)(ws + WS_E), (const float*)(ws + WS_SSQ), P.ple_g});
    }
#undef IN
#undef SEAM
}

extern "C" void kernel_launch(void* const* d_in, const int* in_sizes, int n_in, void* d_out, int out_size, void* d_ws, size_t ws_size, hipStream_t stream) {
    static int grid = 0;
    if (grid == 0) {
        if (n_in != 21 || (size_t)out_size != O_END || ws_size < WS_END) { fprintf(stderr, "kernel_launch: unexpected shapes: n_in %d out %d ws %zu (need %zu); nothing launched\n", n_in, out_size, ws_size, (size_t)WS_END); grid = -1; return; }
        int dev = 0, cus = 0, per_cu = 0;
        if (hipGetDevice(&dev) != hipSuccess || hipDeviceGetAttribute(&cus, hipDeviceAttributeMultiprocessorCount, dev) != hipSuccess) { grid = -1; return; }
        if (hipFuncSetAttribute((const void*)fwd_kernel, hipFuncAttributeMaxDynamicSharedMemorySize, LDS_BYTES) != hipSuccess) { fprintf(stderr, "kernel_launch: hipFuncSetAttribute failed\n"); grid = -1; return; }
        if (hipOccupancyMaxActiveBlocksPerMultiprocessor(&per_cu, (const void*)fwd_kernel, NWAVES * 64, LDS_BYTES) != hipSuccess || per_cu < 1) { fprintf(stderr, "kernel_launch: occupancy query says %d blocks per CU\n", per_cu); }
        (void)hipGetLastError();
        grid = cus;
        if (grid < 128) { fprintf(stderr, "kernel_launch: %d CUs: too few\n", grid); grid = -1; return; }
    }
    if (grid < 0) return;
    if (hipMemsetAsync((char*)d_ws + WS_CTL, 0, CTL_ZERO_BYTES, stream) != hipSuccess) { fprintf(stderr, "kernel_launch: memset failed\n"); return; }
    Params p{};
    const float** pin = (const float**)&p;
    for (int i = 0; i < 21; ++i) pin[i] = (const float*)d_in[i];
    p.out = (float*)d_out; p.ws = (unsigned char*)d_ws;
#if MK_N_LAUNCHES == 1
#ifdef PROBE_PREFIX
    { p.ph_lo = 0; p.ph_hi = PROBE_PREFIX;
#ifdef PROBE_FLAGS
      p.flags = PROBE_FLAGS;
#endif
      void* a0[] = {&p}; (void)hipLaunchCooperativeKernel((const void*)fwd_kernel, dim3(grid), dim3(NWAVES * 64), a0, LDS_BYTES, stream);
      (void)hipMemsetAsync((char*)d_ws + WS_CTL, 0, CTL_ZERO_BYTES, stream); }
#endif
    p.ph_lo = 0; p.ph_hi = N_PHASES; p.flags = 0;
    void* args[] = {&p};
    hipError_t e = hipLaunchCooperativeKernel((const void*)fwd_kernel, dim3(grid), dim3(NWAVES * 64), args, LDS_BYTES, stream);
    if (e != hipSuccess) fprintf(stderr, "kernel_launch: cooperative launch failed: %s (grid %d)\n", hipGetErrorString(e), grid);
#else
    for (int k = 0; k < N_PHASES; ++k) { p.ph_lo = k; p.ph_hi = k + 1;
        hipLaunchKernelGGL(fwd_kernel, dim3(grid), dim3(NWAVES * 64), LDS_BYTES, stream, p);
        const hipError_t le = hipPeekAtLastError(); if (le != hipSuccess) { fprintf(stderr, "kernel_launch: launch %d failed: %s\n", k, hipGetErrorName(le)); break; } }
#endif
}
```

```cpp
#include <hip/hip_runtime.h>
#include <cstdio>
#include <cstdint>
#ifndef MK_N_LAUNCHES
#define MK_N_LAUNCHES 1
#endif
namespace pg8 {
#define PG8_LAS __attribute__((address_space(3)))
typedef unsigned short bf16_t;
typedef short bf16x8 __attribute__((ext_vector_type(8)));
typedef float f32x4 __attribute__((ext_vector_type(4)));
typedef unsigned u32x4 __attribute__((ext_vector_type(4)));
constexpr int BM = 256, BK = 64, HALF = 128, HTB = HALF * BK * 2  , STAGE_BYTES = 8 * HTB, NXCD = 8, WGM = 8;

__host__ __device__ __forceinline__ int lds_byte(int r, int c) { const int st = (r >> 4) * 2 + (c >> 5), rr = r & 15, cc = c & 31, ob = rr * 64 + cc * 2; return st * 1024 + (ob ^ (((ob >> 9) & 1) << 5)); }
__host__ __device__ __forceinline__ void stage_rc(int b, int& R, int& C) { const int st = b / 1024, sb = b % 1024, swz = sb ^ (((sb >> 9) & 1) << 5); R = (st >> 1) * 16 + swz / 64; C = (st & 1) * 32 + (swz % 64) / 2; }
__host__ __device__ __forceinline__ int perm32(int rho) { const int n = rho >> 4, i = rho & 15; return 8 * (i >> 2) + 4 * n + (i & 3); }

struct Unit { int pm, pn; };
struct Gemm { const bf16_t* A; const bf16_t* Bt; int M, N, K; };

struct StaticOrder {
    int nM, nN, nwg, G, c;
    __host__ __device__ void init(int M, int N, int G_, int c_) { nM = M / BM; nN = N / BM; nwg = nM * nN; G = G_; c = c_; }
    __host__ __device__ bool next(int i, Unit& u) const {
        const long L = (long)i * G + c; if (L >= nwg) return false;
        int wgid = (int)L; { const int q = nwg / NXCD, r = nwg % NXCD, xcd = wgid % NXCD, off = wgid / NXCD; wgid = (xcd < r ? xcd * (q + 1) : r * (q + 1) + (xcd - r) * q) + off; }
        const int nig = WGM * nN, gid = wgid / nig, fm = gid * WGM, gsz = (nM - fm) < WGM ? (nM - fm) : WGM;
        u.pm = fm + ((wgid % nig) % gsz); u.pn = (wgid % nig) / gsz; return true;
    }
    __device__ __forceinline__ void a_ready(const Unit&) const {}
    __device__ __forceinline__ void done(const Unit&) const {}
};

typedef float f32x2c __attribute__((ext_vector_type(2))); typedef __bf16 bf16x2c __attribute__((ext_vector_type(2)));
__device__ __forceinline__ unsigned cvt_pk_bf16_v(float lo, float hi) { const f32x2c v = {lo, hi}; const bf16x2c b = __builtin_convertvector(v, bf16x2c); return __builtin_bit_cast(unsigned, b); }
__device__ __forceinline__ unsigned cvt_pk_bf16(float lo, float hi) { unsigned r; asm volatile("v_cvt_pk_bf16_f32 %0, %1, %2" : "=v"(r) : "v"(lo), "v"(hi)); return r; }
typedef unsigned u32x2 __attribute__((ext_vector_type(2)));
constexpr int XCHG_WAVE_BYTES = 2304, XCHG_OFF = 131584;
__device__ __forceinline__ u32x4 xchg_bf16(PG8_LAS unsigned char* xl, int fr, int fq, int l, u32x4 w) {
    *(PG8_LAS u32x4*)(xl + fr * 80 + fq * 16) = w;
    return *(const PG8_LAS u32x4*)(xl + (l >> 2) * 80 + (l & 3) * 16);
}
__device__ __forceinline__ void xchg_f32(PG8_LAS unsigned char* xl, int fr, int fq, int l, const f32x4 v0, const f32x4 v1, f32x4& o0, f32x4& o1) {
    *(PG8_LAS f32x4*)(xl + fr * 144 + fq * 32) = v0; *(PG8_LAS f32x4*)(xl + fr * 144 + fq * 32 + 16) = v1;
    o0 = *(const PG8_LAS f32x4*)(xl + (l >> 3) * 144 + (l & 7) * 16); o1 = *(const PG8_LAS f32x4*)(xl + ((l >> 3) + 8) * 144 + (l & 7) * 16);
}
typedef unsigned u32x2 __attribute__((ext_vector_type(2)));
struct EpiProj {
    static constexpr bool PERM = true, AFTER_DRAIN = false;
    bf16_t* qkva; bf16_t* qkvb; bf16_t* z; PG8_LAS unsigned char* xl0;
    __device__ __forceinline__ void operator()(const f32x4 (&acc)[2][2][4][2], const Unit& u_, int wr, int wc, int fr, int fq) const {
        Unit u = u_; asm volatile("" : "+s"(u.pm), "+s"(u.pn));
        bf16_t* base; int ldc, colt;
        if (u.pn < 6) { base = qkva; ldc = 1536; colt = u.pn * 256; }
        else if (u.pn < 12) { base = qkvb; ldc = 1536; colt = (u.pn - 6) * 256; }
        else { base = z; ldc = 1024; colt = (u.pn - 12) * 256; }
        const int l = fq * 16 + fr; PG8_LAS unsigned char* xl = xl0 + (wr * 4 + wc) * XCHG_WAVE_BYTES;
        const int rowb = u.pm * BM + wr * 64 + (l >> 2); const int colb = colt + wc * 32 + 8 * (l & 3);
#pragma unroll
        for (int ai = 0; ai < 2; ++ai)
#pragma unroll
            for (int m = 0; m < 4; ++m) { bf16_t* rowp = base + (size_t)(rowb + ai * HALF + m * 16) * ldc + colb;
#pragma unroll
                for (int bj = 0; bj < 2; ++bj) { const f32x4 v0 = acc[ai][bj][m][0], v1 = acc[ai][bj][m][1];
                    u32x4 w; w.x = cvt_pk_bf16(v0[0], v0[1]); w.y = cvt_pk_bf16(v0[2], v0[3]); w.z = cvt_pk_bf16(v1[0], v1[1]); w.w = cvt_pk_bf16(v1[2], v1[3]);
                    *(u32x4*)(rowp + bj * HALF) = xchg_bf16(xl, fr, fq, l, w); } }
    }
};
struct EpiE {
    static constexpr bool PERM = true, AFTER_DRAIN = false;
    bf16_t* E; float* ssq; PG8_LAS unsigned char* xl0;
    __device__ __forceinline__ void operator()(const f32x4 (&acc)[2][2][4][2], const Unit& u_, int wr, int wc, int fr, int fq) const {
        Unit u = u_; asm volatile("" : "+s"(u.pm), "+s"(u.pn));
        const int l = fq * 16 + fr; PG8_LAS unsigned char* xl = xl0 + (wr * 4 + wc) * XCHG_WAVE_BYTES;
        const int row0 = u.pm * BM + wr * 64 + fr;
        const int rowb = u.pm * BM + wr * 64 + (l >> 2); const int colb = u.pn * BM + wc * 32 + 8 * (l & 3);
#pragma unroll
        for (int ai = 0; ai < 2; ++ai)
#pragma unroll
            for (int m = 0; m < 4; ++m) { const int row = row0 + ai * HALF + m * 16; bf16_t* rowp = E + (size_t)(rowb + ai * HALF + m * 16) * 1024 + colb; float s = 0.f;
#pragma unroll
                for (int bj = 0; bj < 2; ++bj) { const f32x4 v0 = acc[ai][bj][m][0], v1 = acc[ai][bj][m][1];
                    s += (v0[0] * v0[0] + v0[1] * v0[1]) + (v0[2] * v0[2] + v0[3] * v0[3]) + (v1[0] * v1[0] + v1[1] * v1[1]) + (v1[2] * v1[2] + v1[3] * v1[3]);
                    u32x4 w; w.x = cvt_pk_bf16(v0[0], v0[1]); w.y = cvt_pk_bf16(v0[2], v0[3]); w.z = cvt_pk_bf16(v1[0], v1[1]); w.w = cvt_pk_bf16(v1[2], v1[3]);
                    *(u32x4*)(rowp + bj * HALF) = xchg_bf16(xl, fr, fq, l, w); }
                s += __shfl_xor(s, 16); s += __shfl_xor(s, 32);
                if (fq == 0) atomicAdd(ssq + row, s);
                asm volatile("" ::: "memory"); }
    }
};
struct EpiOut {
    static constexpr bool PERM = false, AFTER_DRAIN = false;
    const float* xp; const float* xs; float* y; bf16_t* h1b;
    __device__ __forceinline__ void operator()(const f32x4 (&acc)[2][2][4][2], const Unit& u_, int wr, int wc, int fr, int fq) const {
        Unit u = u_; asm volatile("" : "+s"(u.pm), "+s"(u.pn));
        const int col0 = u.pn * BM + wc * 32 + 4 * fq;
#pragma unroll
        for (int ai = 0; ai < 2; ++ai)
#pragma unroll
            for (int m = 0; m < 4; ++m) { const int row = u.pm * BM + ai * HALF + wr * 64 + m * 16 + fr;
                const float* xrow = (u.pm < 256) ? xp + (size_t)row * 1024 : xs + (size_t)(row - 65536) * 1024;
#pragma unroll
                for (int bj = 0; bj < 2; ++bj)
#pragma unroll
                    for (int n = 0; n < 2; ++n) { const int col = col0 + bj * HALF + n * 16;
                        const f32x4 h = *(const f32x4*)(xrow + col) + acc[ai][bj][m][n];
                        *(f32x4*)(y + (size_t)row * 1024 + col) = h;
                        u32x2 w; w.x = cvt_pk_bf16(h[0], h[1]); w.y = cvt_pk_bf16(h[2], h[3]); *(u32x2*)(h1b + (size_t)row * 1024 + col) = w; }
                if (m & 1) asm volatile("" ::: "memory"); }
    }
};
struct EpiGate {
    static constexpr bool PERM = false, AFTER_DRAIN = false;
    float* y; const bf16_t* E; const float* ssq; const float* pg;
    __device__ __forceinline__ void operator()(const f32x4 (&acc)[2][2][4][2], const Unit& u_, int wr, int wc, int fr, int fq) const {
        Unit u = u_; asm volatile("" : "+s"(u.pm), "+s"(u.pn));
        const int col0 = u.pn * BM + wc * 32 + 4 * fq;
        f32x4 g4[2][2];
#pragma unroll
        for (int bj = 0; bj < 2; ++bj)
#pragma unroll
            for (int n = 0; n < 2; ++n) g4[bj][n] = *(const f32x4*)(pg + col0 + bj * HALF + n * 16);
#pragma unroll
        for (int ai = 0; ai < 2; ++ai)
#pragma unroll
            for (int m = 0; m < 4; ++m) { const int row = u.pm * BM + ai * HALF + wr * 64 + m * 16 + fr;
                const float rstd = __builtin_amdgcn_rsqf(ssq[row] * (1.0f / 1024.0f) + 1e-6f);
#pragma unroll
                for (int bj = 0; bj < 2; ++bj)
#pragma unroll
                    for (int n = 0; n < 2; ++n) { const int col = col0 + bj * HALF + n * 16; const size_t off = (size_t)row * 1024 + col;
                        const f32x4 h = *(const f32x4*)(y + off); const u32x2 eb = *(const u32x2*)(E + off); const f32x4 a = acc[ai][bj][m][n];
                        f32x4 e; e[0] = __uint_as_float(eb.x << 16); e[1] = __uint_as_float(eb.x & 0xffff0000u); e[2] = __uint_as_float(eb.y << 16); e[3] = __uint_as_float(eb.y & 0xffff0000u);
                        f32x4 o;
#pragma unroll
                        for (int i = 0; i < 4; ++i) { const float sg = __builtin_amdgcn_rcpf(1.0f + __expf(-a[i])); o[i] = h[i] + sg * (e[i] * rstd * g4[bj][n][i]); }
                        *(f32x4*)(y + off) = o; }
                if (m & 1) asm volatile("" ::: "memory"); }
    }
};
struct PanelOrder { int pm, n, first, dpm, dpn;
    __device__ __forceinline__ bool next(int i, Unit& u) const { if (i >= n) return false; u.pm = pm + i * dpm; u.pn = first + i * dpn; return true; }
    __device__ __forceinline__ void a_ready(const Unit&) const {}
    __device__ __forceinline__ void done(const Unit&) const {} };
struct EpiOutB {
    static constexpr bool PERM = true, AFTER_DRAIN = false;
    const float* xp; bf16_t* h1b; PG8_LAS unsigned char* xl0;
    __device__ __forceinline__ void operator()(const f32x4 (&acc)[2][2][4][2], const Unit& u_, int wr, int wc, int fr, int fq) const {
        Unit u = u_; asm volatile("" : "+s"(u.pm), "+s"(u.pn));
        const int l = fq * 16 + fr; PG8_LAS unsigned char* xl = xl0 + (wr * 4 + wc) * XCHG_WAVE_BYTES;
        const int rowb = u.pm * BM + wr * 64 + (l >> 3); const int colb = u.pn * BM + wc * 32 + 4 * (l & 7);
#pragma unroll
        for (int ai = 0; ai < 2; ++ai) {
            f32x4 xr[4][2][2];
#pragma unroll
            for (int m = 0; m < 4; ++m)
#pragma unroll
                for (int bj = 0; bj < 2; ++bj)
#pragma unroll
                    for (int t = 0; t < 2; ++t) xr[m][bj][t] = *(const f32x4*)(xp + (size_t)(rowb + ai * HALF + m * 16 + 8 * t) * 1024 + colb + bj * HALF);
            asm volatile("" ::: "memory");
#pragma unroll
            for (int m = 0; m < 4; ++m)
#pragma unroll
                for (int bj = 0; bj < 2; ++bj) { f32x4 o[2]; xchg_f32(xl, fr, fq, l, acc[ai][bj][m][0], acc[ai][bj][m][1], o[0], o[1]);
#pragma unroll
                    for (int t = 0; t < 2; ++t) { const f32x4 v = o[t] + xr[m][bj][t]; u32x2 w; w.x = cvt_pk_bf16_v(v[0], v[1]); w.y = cvt_pk_bf16_v(v[2], v[3]);
                        *(u32x2*)(h1b + (size_t)(rowb + ai * HALF + m * 16 + 8 * t) * 1024 + colb + bj * HALF) = w; } }
            asm volatile("" ::: "memory");
        }
    }
};
struct EpiGateB {
    static constexpr bool PERM = true, AFTER_DRAIN = false;
    float* y; const bf16_t* h1b; const bf16_t* E; const float* ssq; const float* pg; PG8_LAS unsigned char* xl0;
    __device__ __forceinline__ void operator()(const f32x4 (&acc)[2][2][4][2], const Unit& u_, int wr, int wc, int fr, int fq) const {
        Unit u = u_; asm volatile("" : "+s"(u.pm), "+s"(u.pn));
        const int l = fq * 16 + fr; PG8_LAS unsigned char* xl = xl0 + (wr * 4 + wc) * XCHG_WAVE_BYTES;
        const int rowb = u.pm * BM + wr * 64 + (l >> 3); const int colb = u.pn * BM + wc * 32 + 4 * (l & 7);
        f32x4 g4[2];
#pragma unroll
        for (int bj = 0; bj < 2; ++bj) g4[bj] = *(const f32x4*)(pg + colb + bj * HALF);
#pragma unroll
        for (int am = 0; am < 4; ++am) { const int ai = am >> 1, m0 = (am & 1) * 2;
            u32x2 hb[2][2][2], eb[2][2][2]; float sq[2][2];
#pragma unroll
            for (int m = 0; m < 2; ++m)
#pragma unroll
                for (int t = 0; t < 2; ++t) { const int row = rowb + ai * HALF + (m0 + m) * 16 + 8 * t; const size_t off = (size_t)row * 1024 + colb; sq[m][t] = ssq[row];
#pragma unroll
                    for (int bj = 0; bj < 2; ++bj) { hb[m][bj][t] = *(const u32x2*)(h1b + off + bj * HALF); eb[m][bj][t] = *(const u32x2*)(E + off + bj * HALF); } }
            asm volatile("" ::: "memory");
#pragma unroll
            for (int m = 0; m < 2; ++m) {
                const float rstd[2] = {__builtin_amdgcn_rsqf(sq[m][0] * (1.0f / 1024.0f) + 1e-6f), __builtin_amdgcn_rsqf(sq[m][1] * (1.0f / 1024.0f) + 1e-6f)};
#pragma unroll
                for (int bj = 0; bj < 2; ++bj) { f32x4 a[2]; xchg_f32(xl, fr, fq, l, acc[ai][bj][m0 + m][0], acc[ai][bj][m0 + m][1], a[0], a[1]);
#pragma unroll
                    for (int t = 0; t < 2; ++t) { const unsigned hw[2] = {hb[m][bj][t].x, hb[m][bj][t].y}, ew[2] = {eb[m][bj][t].x, eb[m][bj][t].y};
                        f32x4 o;
#pragma unroll
                        for (int i = 0; i < 4; ++i) { const float h = (i & 1) ? __uint_as_float(hw[i >> 1] & 0xffff0000u) : __uint_as_float(hw[i >> 1] << 16);
                            const float ee = (i & 1) ? __uint_as_float(ew[i >> 1] & 0xffff0000u) : __uint_as_float(ew[i >> 1] << 16);
                            const float sg = __builtin_amdgcn_rcpf(1.0f + __expf(-a[t][i]));
                            o[i] = h + sg * (ee * rstd[t] * g4[bj][i]); }
                        *(f32x4*)(y + (size_t)(rowb + ai * HALF + (m0 + m) * 16 + 8 * t) * 1024 + colb + bj * HALF) = o; } } }
            asm volatile("" ::: "memory");
        }
    }
};
template <class Epi, class Sched, bool ALIGN_EPI = false, bool SP2 = false>
__device__ __forceinline__ void gemm_phase(PG8_LAS unsigned char* lds, const Gemm g, const Sched& S, const Epi& E) {
    int tid_l = threadIdx.x; asm volatile("" : "+v"(tid_l));
    const int tid = tid_l, wid = __builtin_amdgcn_readfirstlane(tid >> 6), lane = tid & 63, wr = wid >> 2, wc = wid & 3, fr = lane & 15, fq = lane >> 4;
    const int K = g.K, nt = K / BK;
    unsigned voffA[2], voffB[2];
#pragma unroll
    for (int i = 0; i < 2; ++i) { int R, C; stage_rc(tid * 16 + i * 8192, R, C); const int Rb = Epi::PERM ? ((R & ~31) + perm32(R & 31)) : R;
        voffA[i] = (unsigned)(R * K + C) * 2u; voffB[i] = (unsigned)(Rb * K + C) * 2u; }
    const size_t kstep = (size_t)(BK * 2);
    const size_t hstep = (size_t)HALF * K * 2;
    const size_t tstep = 2 * hstep;
    const unsigned ldsw = (unsigned)wid * 1024u;
    const int aoff = lds_byte(wr * 64 + fr, fq * 8), boff = lds_byte(wc * 32 + fr, fq * 8);
#define PG8_SA(b, h) (((b) * 2 + (h)) * HTB)
#define PG8_SB(b, h) ((4 + (b) * 2 + (h)) * HTB)
#define PG8_STAGE(bufoff, gbase, voff) do { _Pragma("unroll") for (int _i = 0; _i < 2; ++_i) \
        __builtin_amdgcn_global_load_lds((const unsigned*)((const char*)(gbase) + (voff)[_i]), (PG8_LAS unsigned*)(lds + (bufoff) + ldsw + _i * 8192), 16, 0, 0); } while (0)
#define PG8_LDA(dst, b, h) do { _Pragma("unroll") for (int m = 0; m < 4; ++m) _Pragma("unroll") for (int k = 0; k < 2; ++k) dst[m][k] = *(const PG8_LAS bf16x8*)(lds + PG8_SA(b, h) + aoff + m * 2048 + k * 1024); } while (0)
#define PG8_LDB(dst, b, h) do { _Pragma("unroll") for (int n = 0; n < 2; ++n) _Pragma("unroll") for (int k = 0; k < 2; ++k) dst[n][k] = *(const PG8_LAS bf16x8*)(lds + PG8_SB(b, h) + boff + n * 2048 + k * 1024); } while (0)
#define PG8_MMA(ai, bj, At, Bt) do { __builtin_amdgcn_s_setprio(1); _Pragma("unroll") for (int m = 0; m < 4; ++m) _Pragma("unroll") for (int n = 0; n < 2; ++n) _Pragma("unroll") for (int k = 0; k < 2; ++k) \
        acc[ai][bj][m][n] = __builtin_amdgcn_mfma_f32_16x16x32_bf16(Bt[n][k], At[m][k], acc[ai][bj][m][n], 0, 0, 0); __builtin_amdgcn_s_setprio(0); } while (0)
#define PG8_WAIT_V(n) asm volatile("s_waitcnt vmcnt(" #n ")" ::: "memory")
#define PG8_WAIT_L(n) asm volatile("s_waitcnt lgkmcnt(" #n ")" ::: "memory")
#define PG8_BAR __builtin_amdgcn_s_barrier()
#define PG8_SCHED __builtin_amdgcn_sched_barrier(0)
    Unit cur, nxt; int ui = 0;
    if (!S.next(0, cur)) return;
    f32x4 acc[2][2][4][2];
#pragma unroll
    for (int a = 0; a < 2; ++a)
#pragma unroll
        for (int b = 0; b < 2; ++b)
#pragma unroll
            for (int m = 0; m < 4; ++m)
#pragma unroll
                for (int n = 0; n < 2; ++n) acc[a][b][m][n] = (f32x4){0.f, 0.f, 0.f, 0.f};
    bf16x8 At[4][2], B0[2][2], B1[2][2];
    const char* cA = (const char*)g.A + (size_t)cur.pm * tstep; const char* cB = (const char*)g.Bt + (size_t)cur.pn * tstep;
    S.a_ready(cur);
    if constexpr (SP2) {
        PG8_STAGE(PG8_SB(0, 0), cB, voffB); PG8_STAGE(PG8_SB(0, 1), cB + hstep, voffB); PG8_STAGE(PG8_SA(0, 0), cA, voffA); PG8_STAGE(PG8_SA(0, 1), cA + hstep, voffA);
        if (wr == 1) PG8_BAR;
        PG8_WAIT_V(2); PG8_BAR;
        PG8_STAGE(PG8_SB(1, 0), cB + kstep, voffB); PG8_STAGE(PG8_SA(1, 0), cA + kstep, voffA); PG8_STAGE(PG8_SB(1, 1), cB + hstep + kstep, voffB);
        PG8_WAIT_V(6); PG8_BAR;
    } else {
        PG8_STAGE(PG8_SB(0, 0), cB, voffB); PG8_STAGE(PG8_SA(0, 0), cA, voffA); PG8_STAGE(PG8_SB(0, 1), cB + hstep, voffB); PG8_STAGE(PG8_SA(0, 1), cA + hstep, voffA);
        if (wr == 1) PG8_BAR;
        PG8_WAIT_V(4); PG8_BAR;
        PG8_STAGE(PG8_SB(1, 0), cB + kstep, voffB); PG8_STAGE(PG8_SA(1, 0), cA + kstep, voffA); PG8_STAGE(PG8_SB(1, 1), cB + hstep + kstep, voffB);
        PG8_WAIT_V(6); PG8_BAR;
    }
    for (;;) {
        const bool has_next = S.next(ui + 1, nxt);
        const char* nA = has_next ? (const char*)g.A + (size_t)nxt.pm * tstep : cA; const char* nB = has_next ? (const char*)g.Bt + (size_t)nxt.pn * tstep : cB;
        for (int t = 0; t < nt; t += 2) {
            const bool last = (t == nt - 2);
            const char* a1 = cA + (size_t)(t + 1) * kstep;
            const char* a2 = last ? nA : cA + (size_t)(t + 2) * kstep; const char* b2 = last ? nB : cB + (size_t)(t + 2) * kstep;
            const char* a3 = a2 + kstep; const char* b3 = b2 + kstep;
            if (last && has_next) S.a_ready(nxt);
            if constexpr (SP2) {
            PG8_LDB(B0, 0, 0); PG8_LDB(B1, 0, 1); PG8_SCHED; PG8_LDA(At, 0, 0); PG8_STAGE(PG8_SA(1, 1), a1 + hstep, voffA);
            PG8_WAIT_V(8); PG8_WAIT_L(0); PG8_BAR; PG8_MMA(0, 0, At, B0); PG8_MMA(0, 1, At, B1); PG8_BAR; PG8_SCHED;
            PG8_LDA(At, 0, 1); PG8_STAGE(PG8_SB(0, 0), b2, voffB); PG8_STAGE(PG8_SB(0, 1), b2 + hstep, voffB); PG8_STAGE(PG8_SA(0, 0), a2, voffA);
            PG8_WAIT_V(8); PG8_WAIT_L(0); PG8_BAR; PG8_MMA(1, 0, At, B0); PG8_MMA(1, 1, At, B1); PG8_BAR; PG8_SCHED;
            PG8_LDB(B0, 1, 0); PG8_LDB(B1, 1, 1); PG8_SCHED; PG8_LDA(At, 1, 0); PG8_STAGE(PG8_SA(0, 1), a2 + hstep, voffA);
            PG8_WAIT_V(8); PG8_WAIT_L(0); PG8_BAR; PG8_MMA(0, 0, At, B0); PG8_MMA(0, 1, At, B1); PG8_BAR; PG8_SCHED;
            PG8_LDA(At, 1, 1); PG8_STAGE(PG8_SB(1, 0), b3, voffB); PG8_STAGE(PG8_SB(1, 1), b3 + hstep, voffB); PG8_STAGE(PG8_SA(1, 0), a3, voffA);
            PG8_WAIT_V(8); PG8_WAIT_L(0); PG8_BAR; PG8_MMA(1, 0, At, B0); PG8_MMA(1, 1, At, B1); PG8_BAR; PG8_SCHED;
            } else {
            PG8_LDB(B0, 0, 0); PG8_SCHED; PG8_LDA(At, 0, 0); PG8_STAGE(PG8_SA(1, 1), a1 + hstep, voffA);
            PG8_WAIT_L(8); PG8_BAR; PG8_WAIT_L(0); PG8_MMA(0, 0, At, B0); PG8_BAR; PG8_SCHED;
            PG8_LDB(B1, 0, 1); PG8_STAGE(PG8_SB(0, 0), b2, voffB);
            PG8_BAR; PG8_WAIT_L(0); PG8_MMA(0, 1, At, B1); PG8_BAR;
            PG8_LDA(At, 0, 1); PG8_STAGE(PG8_SA(0, 0), a2, voffA);
            PG8_BAR; PG8_WAIT_L(0); PG8_MMA(1, 0, At, B0); PG8_BAR; PG8_SCHED;
            PG8_STAGE(PG8_SB(0, 1), b2 + hstep, voffB);
            PG8_WAIT_V(6); PG8_BAR; PG8_MMA(1, 1, At, B1); PG8_BAR;
            PG8_LDB(B0, 1, 0); PG8_SCHED; PG8_LDA(At, 1, 0); PG8_STAGE(PG8_SA(0, 1), a2 + hstep, voffA);
            PG8_WAIT_L(8); PG8_BAR; PG8_WAIT_L(0); PG8_MMA(0, 0, At, B0); PG8_BAR; PG8_SCHED;
            PG8_LDB(B1, 1, 1); PG8_STAGE(PG8_SB(1, 0), b3, voffB);
            PG8_BAR; PG8_WAIT_L(0); PG8_MMA(0, 1, At, B1); PG8_BAR;
            PG8_LDA(At, 1, 1); PG8_STAGE(PG8_SA(1, 0), a3, voffA);
            PG8_BAR; PG8_WAIT_L(0); PG8_MMA(1, 0, At, B0); PG8_BAR; PG8_SCHED;
            PG8_STAGE(PG8_SB(1, 1), b3 + hstep, voffB);
            PG8_WAIT_V(6); PG8_BAR; PG8_MMA(1, 1, At, B1); PG8_BAR;
            }
        }
        if constexpr (ALIGN_EPI) { if (wr == 0) PG8_BAR; }
        if constexpr (!Epi::AFTER_DRAIN) { E(acc, cur, wr, wc, fr, fq); S.done(cur); }
        if (!has_next) break;
#pragma unroll
        for (int a = 0; a < 2; ++a)
#pragma unroll
            for (int b = 0; b < 2; ++b)
#pragma unroll
                for (int m = 0; m < 4; ++m)
#pragma unroll
                    for (int n = 0; n < 2; ++n) acc[a][b][m][n] = (f32x4){0.f, 0.f, 0.f, 0.f};
        cur = nxt; cA = nA; cB = nB; ++ui;
        if constexpr (ALIGN_EPI) { if (wr == 1) PG8_BAR; }
    }
    PG8_WAIT_V(0);
    if constexpr (!ALIGN_EPI) { if (wr == 0) PG8_BAR; }
    PG8_BAR;
    if constexpr (Epi::AFTER_DRAIN) { E.fused(acc, cur, wr, wc, fr, fq, lds, wid, lane); S.done(cur); }
#undef PG8_SA
#undef PG8_SB
#undef PG8_STAGE
#undef PG8_LDA
#undef PG8_LDB
#undef PG8_MMA
#undef PG8_WAIT_V
#undef PG8_WAIT_L
#undef PG8_BAR
#undef PG8_SCHED
}
}

#ifndef PG8_SP2
#define PG8_SP2 true
#endif
#ifndef PG8_ALIGN
#define PG8_ALIGN true
#endif
constexpr int NWAVES = 8;
constexpr int DM = 1024, TP = 8192, NBP = 8, MP = NBP * TP, NBS = 16, TS = 16, MS = NBS * TS, M = MP + MS;
constexpr int NCU = NBP * 128 + NBS;
constexpr int LDW_IN = 4112;
constexpr size_t O_Y = 0, O_CP = 67371008, O_GP = 67407872, O_KP = 67670016, O_VP = 69767168, O_CS = 71864320, O_GS = 71938048, O_KS = 72462336, O_VS = 72593408, O_END = 72724480;
constexpr size_t MiB = 1u << 20;
constexpr size_t WS_CTL = 0, CTL_ZERO_BYTES = 64 * 1024;
constexpr size_t WS_WIN = 1 * MiB, WS_WOUT = 9 * MiB, WS_WGATE = 11 * MiB, WS_WPLE = 13 * MiB;
constexpr size_t WS_WAB = 13 * MiB + 768 * 1024;
constexpr size_t WS_G = 14 * MiB, WS_BETA = 17 * MiB, WS_GT = 20 * MiB, WS_SSQ = 20 * MiB + 512 * 1024;
constexpr size_t WS_PB = 21 * MiB;
constexpr size_t WS_Z = 54 * MiB;
constexpr size_t WS_QKVA = 183 * MiB;
constexpr size_t WS_QKVB = 376 * MiB;
constexpr size_t WS_OPS = 569 * MiB;
constexpr size_t WS_QF = 894 * MiB;
constexpr size_t WS_KFS = 958 * MiB, WS_VFS = 968 * MiB, WS_QFS = 978 * MiB, WS_OAS = 979 * MiB, WS_END = 980 * MiB;
constexpr size_t WS_MIX = WS_QKVA, WS_H1B = WS_QKVB, WS_XN = WS_OPS, WS_E = WS_OPS;
constexpr size_t YO_KF = 0, YO_VF = 64 * MiB, YO_OA = 128 * MiB;
constexpr int CW_BAR = 4096, CW_ATT = 8192, CW_QD = 10240  , CW_BP = 12288;
constexpr int OPS_UNIT = 40960, OPS_W = 0, OPS_KT = 8192, OPS_QD = 16384, OPS_QK = 24576, OPS_U = 32768;
constexpr int RING_BYTES = 131072, LDSCTL_OFF = RING_BYTES, MISC_OFF = LDSCTL_OFF + 320, LDS_BYTES = 163840;

#define GAS __attribute__((address_space(1)))
#define LAS __attribute__((address_space(3)))
typedef unsigned short bf16;
typedef unsigned v4u __attribute__((ext_vector_type(4)));
typedef unsigned v2u __attribute__((ext_vector_type(2)));
typedef float f32x4 __attribute__((ext_vector_type(4)));
typedef float f32x16 __attribute__((ext_vector_type(16)));
typedef short bf16x8 __attribute__((ext_vector_type(8)));
typedef GAS unsigned gu32;
#define RLX_AGENT __ATOMIC_RELAXED, __HIP_MEMORY_SCOPE_AGENT
#define LDS_WAIT() asm volatile("s_waitcnt lgkmcnt(0)" ::: "memory")
__device__ __forceinline__ unsigned pk2(float lo, float hi) { return pg8::cvt_pk_bf16_v(lo, hi); }
__device__ __forceinline__ float bflo(unsigned w) { return __uint_as_float(w << 16); }
__device__ __forceinline__ float bfhi(unsigned w) { return __uint_as_float(w & 0xffff0000u); }
__device__ __forceinline__ float bf1(unsigned short b) { return __uint_as_float((unsigned)b << 16); }
__device__ __forceinline__ float siluf(float x) { return x * __builtin_amdgcn_rcpf(1.0f + __expf(-x)); }
__device__ __forceinline__ void glds16_asm(const void* gsrc, LAS unsigned char* lds_dst, bool nt) {
    unsigned keep; const unsigned d = (unsigned)__builtin_amdgcn_readfirstlane((int)(unsigned)(uintptr_t)lds_dst);
    if (nt) asm volatile("s_mov_b32 %0, m0\n\ts_mov_b32 m0, %2\n\ts_nop 0\n\tglobal_load_lds_dwordx4 %1, off nt\n\ts_mov_b32 m0, %0" : "=&s"(keep) : "v"(gsrc), "s"(d) : "memory");
    else    asm volatile("s_mov_b32 %0, m0\n\ts_mov_b32 m0, %2\n\ts_nop 0\n\tglobal_load_lds_dwordx4 %1, off\n\ts_mov_b32 m0, %0" : "=&s"(keep) : "v"(gsrc), "s"(d) : "memory");
}
__device__ __forceinline__ float wave_sum(float v) {
#pragma unroll
    for (int o = 1; o < 64; o <<= 1) v += __shfl_xor(v, o);
    return v;
}
#define XB_TMO      128
#define XB_XCNT(j)  (256  + 64 * (j))
#define XB_XSUB(j)  (1280 + 64 * (j))
#define XB_XGEN(j)  (2304 + 64 * (j))
#define XB_TOP      3328
#define XB_TOPGEN   3392
#define XCD_BAR_WORDS 3456
#define XB_SPIN_CAP (1u << 18)

__device__ __forceinline__ unsigned xb_ld(unsigned* p)              { return __hip_atomic_load(p, __ATOMIC_RELAXED, __HIP_MEMORY_SCOPE_AGENT); }
__device__ __forceinline__ unsigned xb_add(unsigned* p, unsigned v) { return __hip_atomic_fetch_add(p, v, __ATOMIC_RELAXED, __HIP_MEMORY_SCOPE_AGENT); }
__device__ __forceinline__ unsigned xb_xcc_id() { return (unsigned)__builtin_amdgcn_s_getreg((3 << 11) | 20) & 0xFu; }
#define XB_SPIN(cond, bar) do { unsigned _sp = 0; while (cond) { __builtin_amdgcn_s_sleep(1); \
    if ((++_sp & 255u) == 0u) { if (xb_ld(&(bar)[XB_TMO])) break; if (_sp > XB_SPIN_CAP) { atomicAdd(&(bar)[XB_TMO], 1u); break; } } } } while (0)

struct XcdBarrier {
    unsigned* bar; unsigned x;
    volatile LAS unsigned* st;
};

__device__ __forceinline__ XcdBarrier xcd_barrier_post(unsigned* bar, volatile LAS unsigned* st) {
    XcdBarrier b; b.bar = bar; b.x = xb_xcc_id(); b.st = st;
    if (threadIdx.x == 0) (void)xb_add(&bar[XB_XCNT(b.x)], 1u);
    return b;
}
__device__ __forceinline__ void xcd_barrier_complete(unsigned* bar, unsigned x, unsigned& nloc, unsigned& nx) {
    const unsigned G = gridDim.x * gridDim.y * gridDim.z;
    unsigned sum, cnt, mine, sp = 0u;
    for (;;) {
        sum = 0u; cnt = 0u; mine = 0u;
#pragma unroll
        for (unsigned j = 0; j < 16; ++j) { const unsigned c = xb_ld(&bar[XB_XCNT(j)]); sum += c; cnt += (c > 0u) ? 1u : 0u; mine = (j == x) ? c : mine; }
        if (sum == G) break;
        __builtin_amdgcn_s_sleep(1);
        if ((++sp & 255u) == 0u) { if (xb_ld(&bar[XB_TMO])) break; if (sp > XB_SPIN_CAP) { atomicAdd(&bar[XB_TMO], 1u); break; } }
    }
    nloc = mine > 0u ? mine : 1u; nx = cnt > 0u ? cnt : 1u;
}

__device__ __forceinline__ void xcd_barrier(const XcdBarrier& b) {
    asm volatile("s_waitcnt vmcnt(0)" ::: "memory");
    __syncthreads();
    if (threadIdx.x == 0) {
        unsigned* bar = b.bar;
        __builtin_amdgcn_s_waitcnt(0);
        unsigned nloc = b.st[0], nx = b.st[1];
        if (nloc == 0u) { xcd_barrier_complete(bar, b.x, nloc, nx); b.st[0] = nloc; b.st[1] = nx; }
        const unsigned old = xb_add(&bar[XB_XSUB(b.x)], 1u);
        const unsigned gen = old / nloc;
        if (old + 1u == (gen + 1u) * nloc) {
            __builtin_amdgcn_fence(__ATOMIC_RELEASE, "agent");
            asm volatile("s_waitcnt vmcnt(0)" ::: "memory");
            const unsigned og = xb_add(&bar[XB_TOP], 1u);
            const unsigned tg = og / nx;
            if (og + 1u == (tg + 1u) * nx) xb_add(&bar[XB_TOPGEN], 1u);
            else XB_SPIN(xb_ld(&bar[XB_TOPGEN]) == tg, bar);
            __builtin_amdgcn_fence(__ATOMIC_ACQUIRE, "agent");
            xb_add(&bar[XB_XGEN(b.x)], 1u);
            asm volatile("s_waitcnt vmcnt(0)" ::: "memory");
        } else {
            XB_SPIN(xb_ld(&bar[XB_XGEN(b.x)]) == gen, bar);
            __builtin_amdgcn_fence(__ATOMIC_ACQUIRE, "agent");
            asm volatile("s_waitcnt vmcnt(0)" ::: "memory");
        }
    }
    __syncthreads();
}

struct Params {
    const float* x_p; const float* x_s; const float* state_conv; const float* state_gdn; const float* cache_k; const float* cache_v;
    const float* p_p; const float* p_s; const float* ln_g; const float* w_in; const float* conv_w; const float* a_log; const float* dt_bias;
    const float* gdn_g; const float* qn_g; const float* kn_g; const float* rel_bias; const float* w_out; const float* w_ple; const float* ple_g; const float* w_gate;
    float* out; unsigned char* ws; int ph_lo, ph_hi, flags, pad;
};
__device__ __forceinline__ f32x4 mfma16(bf16x8 a, bf16x8 b, f32x4 c) { return __builtin_amdgcn_mfma_f32_16x16x32_bf16(a, b, c, 0, 0, 0); }
__device__ __forceinline__ f32x16 mfma32(bf16x8 a, bf16x8 b, f32x16 c) { return __builtin_amdgcn_mfma_f32_32x32x16_bf16(a, b, c, 0, 0, 0); }
__device__ __forceinline__ bf16x8 pack8(f32x4 a, f32x4 b) { v4u w; w.x = pk2(a[0], a[1]); w.y = pk2(a[2], a[3]); w.z = pk2(b[0], b[1]); w.w = pk2(b[2], b[3]); return __builtin_bit_cast(bf16x8, w); }
__device__ __forceinline__ void unpack8(v4u w, float (&f)[8]) { f[0] = bflo(w.x); f[1] = bfhi(w.x); f[2] = bflo(w.y); f[3] = bfhi(w.y); f[4] = bflo(w.z); f[5] = bfhi(w.z); f[6] = bflo(w.w); f[7] = bfhi(w.w); }
__device__ __forceinline__ v4u packf8(const float (&f)[8]) { v4u w; w.x = pk2(f[0], f[1]); w.y = pk2(f[2], f[3]); w.z = pk2(f[4], f[5]); w.w = pk2(f[6], f[7]); return w; }

__device__ __forceinline__ void p0_tile(const float* W, int ldw, int srccol0, bf16* WT, int K, int dstrow0, int k0, LAS float* scr, int lane) {
#pragma unroll 8
    for (int i = 0; i < 32; ++i) { const int kk = 2 * i + (lane >> 5); scr[kk * 33 + (lane & 31)] = W[(size_t)(k0 + kk) * ldw + srccol0 + (lane & 31)]; }
    LDS_WAIT(); asm volatile("" ::: "memory");
    const int c = lane & 7;
#pragma unroll
    for (int j = 0; j < 4; ++j) { const int n = (lane >> 3) + 8 * j; const LAS float* s = scr + (8 * c) * 33 + n;
        v4u o; o.x = pk2(s[0 * 33], s[1 * 33]); o.y = pk2(s[2 * 33], s[3 * 33]); o.z = pk2(s[4 * 33], s[5 * 33]); o.w = pk2(s[6 * 33], s[7 * 33]);
        *(v4u*)(WT + (size_t)(dstrow0 + n) * K + k0 + 8 * c) = o; }
    LDS_WAIT(); asm volatile("" ::: "memory");
}
__device__ __forceinline__ void phase0(const Params& P, LAS unsigned char* lds, int tid, int lane, int wave, int G) {
    unsigned char* ws = P.ws;
    const int gw = blockIdx.x * NWAVES + wave, NGW = G * NWAVES;
    LAS float* scr = (LAS float*)(lds + wave * 16384);
    bf16* WIN = (bf16*)(ws + WS_WIN); bf16* WOUT = (bf16*)(ws + WS_WOUT); bf16* WGATE = (bf16*)(ws + WS_WGATE); bf16* WPLE = (bf16*)(ws + WS_WPLE);
    constexpr int I_IN = 128 * 16, I_SQ = 32 * 16, I_PLE = 32 * 4, NITEMS = I_IN + 2 * I_SQ + I_PLE;
    for (int it = gw; it < NITEMS; it += NGW) {
        int r = it;
        if (r < I_IN) { const int n0 = 32 * (r & 127), kb = r >> 7; const int src = n0 < 1536 ? n0 : (n0 < 3072 ? n0 + 528 : (n0 < 3584 ? n0 - 1520 : n0 + 16));
            p0_tile(P.w_in, LDW_IN, src, WIN, 1024, n0, 64 * kb, scr, lane); continue; }
        r -= I_IN;
        if (r < I_SQ) { p0_tile(P.w_out, 1024, 32 * (r & 31), WOUT, 1024, 32 * (r & 31), 64 * (r >> 5), scr, lane); continue; }
        r -= I_SQ;
        if (r < I_SQ) { p0_tile(P.w_gate, 1024, 32 * (r & 31), WGATE, 1024, 32 * (r & 31), 64 * (r >> 5), scr, lane); continue; }
        r -= I_SQ;
        p0_tile(P.w_ple, 1024, 32 * (r & 31), WPLE, 256, 32 * (r & 31), 64 * (r >> 5), scr, lane);
    }
    {
        bf16* WAB = (bf16*)(ws + WS_WAB);
        for (int idx = blockIdx.x * 512 + tid; idx < 16384; idx += G * 512) { const int k = idx >> 4, c = idx & 15; WAB[c * 1024 + k] = (bf16)(pk2(P.w_in[(size_t)k * LDW_IN + 1536 + c], 0.f) & 0xffffu); }
    }
    f32x4 lg[4];
#pragma unroll
    for (int j = 0; j < 4; ++j) lg[j] = ((const f32x4*)P.ln_g)[64 * j + lane];
    bf16* XN = (bf16*)(ws + WS_XN);
    f32x4 rb0[4], rb1[4], rb2[4];
#define P0_LOADROW(buf, mm) do { const int m_ = (mm); if (m_ < M) { const float* xr_ = m_ < MP ? P.x_p + (size_t)m_ * 1024 : P.x_s + (size_t)(m_ - MP) * 1024; \
        _Pragma("unroll") for (int j = 0; j < 4; ++j) buf[j] = ((const f32x4*)xr_)[64 * j + lane]; } } while (0)
#define P0_DOROW(buf, mm) do { const int m_ = (mm); if (m_ < M) { float ss = 0.f; \
        _Pragma("unroll") for (int j = 0; j < 4; ++j) ss += (buf[j][0] * buf[j][0] + buf[j][1] * buf[j][1]) + (buf[j][2] * buf[j][2] + buf[j][3] * buf[j][3]); \
        ss = wave_sum(ss); const float rstd = __builtin_amdgcn_rsqf(ss * (1.0f / 1024.0f) + 1e-6f); \
        v2u* o8 = (v2u*)(XN + (size_t)m_ * 1024) + lane; \
        _Pragma("unroll") for (int j = 0; j < 4; ++j) { const f32x4 v_ = buf[j] * rstd * lg[j]; v2u o; o.x = pk2(v_[0], v_[1]); o.y = pk2(v_[2], v_[3]); o8[64 * j] = o; } } } while (0)
    P0_LOADROW(rb0, gw); P0_LOADROW(rb1, gw + NGW); P0_LOADROW(rb2, gw + 2 * NGW);
    for (int m = gw; m < M; m += 3 * NGW) {
        P0_DOROW(rb0, m);           P0_LOADROW(rb0, m + 3 * NGW);
        P0_DOROW(rb1, m + NGW);     P0_LOADROW(rb1, m + 4 * NGW);
        P0_DOROW(rb2, m + 2 * NGW); P0_LOADROW(rb2, m + 5 * NGW);
    }
#undef P0_LOADROW
#undef P0_DOROW
    bf16* PB = (bf16*)(ws + WS_PB);
    for (int m0 = gw; m0 < M; m0 += 4 * NGW) {
        f32x4 pv[4];
#pragma unroll
        for (int k = 0; k < 4; ++k) { const int m = m0 + k * NGW; if (m < M) { const float* prow = m < MP ? P.p_p + (size_t)m * 256 : P.p_s + (size_t)(m - MP) * 256; pv[k] = ((const f32x4*)prow)[lane]; } }
#pragma unroll
        for (int k = 0; k < 4; ++k) { const int m = m0 + k * NGW; if (m < M) { v2u o; o.x = pk2(pv[k][0], pv[k][1]); o.y = pk2(pv[k][2], pv[k][3]); ((v2u*)(PB + (size_t)m * 256))[lane] = o; } }
    }
    float* ssq = (float*)(ws + WS_SSQ);
    for (int i = blockIdx.x * 512 + tid; i < M; i += G * 512) ssq[i] = 0.f;
}
constexpr int QB_OFF = 0, KB_OFF = 9216, VB_OFF = 18432, XQK_OFF = 27648, XW_OFF = 27648, RAW_OFF = 27648  , LM_OFF = 36864, SC_OFF = 54272, DI_OFF = 55552, CW_OFF = 59648, SC2_OFF = 62720  , HEAD_LDS = 64000;
struct GdnItem { int cu, s, c, L, m0; bool smp; };
__device__ __forceinline__ GdnItem gdn_item(int item) { GdnItem I; I.cu = item >> 2; I.smp = I.cu >= 1024; I.s = I.smp ? I.cu - 1024 : I.cu >> 7; I.c = I.smp ? 0 : I.cu & 127; I.L = I.smp ? 16 : 64; I.m0 = I.smp ? MP + I.s * 16 : I.s * TP + I.c * 64; return I; }
__device__ __forceinline__ void split4(f32x4 x, f32x4& hi, f32x4& lo) {
#pragma unroll
    for (int i = 0; i < 4; ++i) { const float h = __uint_as_float(pk2(x[i], 0.f) << 16); hi[i] = h; lo[i] = x[i] - h; }
}
__device__ __forceinline__ void gdn_prep_all(const Params& P, LAS unsigned char* lds, int tid, int lane, int wave, int G) {
    const int hh = wave >> 2, tih = tid & 255, wq = wave & 3;
    LAS unsigned char* hb = lds + hh * HEAD_LDS;
    LAS float* const scb0 = (LAS float*)(hb + SC_OFF); LAS float* const scb1 = (LAS float*)(hb + SC2_OFF);
    int par = 0;
    const float* Gd = (const float*)(P.ws + WS_G); const float* Bd = (const float*)(P.ws + WS_BETA); float* GT = (float*)(P.ws + WS_GT);
    const bf16* QKVA = (const bf16*)(P.ws + WS_QKVA);
    const int t1 = tih >> 2, cg = tih & 3;
    v4u pre[7]; float gpre = 0.f, bpre = 0.f;
    int cw_hp = -1;
    const f32x4 z4 = {0.f, 0.f, 0.f, 0.f};
#define GDN_PREFETCH(itemv) do { const GdnItem J = gdn_item(itemv); const int hJ = 2 * ((itemv) & 3) + hh; \
        if (wq == 0) { gpre = 0.f; bpre = 0.f; if (lane < J.L) { gpre = Gd[(size_t)(J.m0 + lane) * 8 + hJ]; bpre = Bd[(size_t)(J.m0 + lane) * 8 + hJ]; } }     \
        _Pragma("unroll") for (int k = 0; k < 7; ++k) { const int q = tih + 256 * k, rr = q / 24, pc = q - rr * 24, r = rr - 3, col = (pc >> 3) * 512 + hJ * 64 + (pc & 7) * 8; \
            v4u w = {0u, 0u, 0u, 0u}; \
            if (q < 1608 && r < J.L) { \
                if (r >= 0 || (!J.smp && J.c > 0)) w = *(const v4u*)(QKVA + (size_t)((long)J.m0 + r) * 1536 + col); \
                else if (J.smp) { const float* sp = P.state_conv + ((size_t)J.s * 3 + rr) * 1536 + col; const f32x4 a = ((const f32x4*)sp)[0], b = ((const f32x4*)sp)[1]; \
                    w.x = pk2(a[0], a[1]); w.y = pk2(a[2], a[3]); w.z = pk2(b[0], b[1]); w.w = pk2(b[2], b[3]); } } \
            pre[k] = w; } } while (0)
#define GDN_GATES(scd, itemv) do { const GdnItem Jg = gdn_item(itemv); const int hg = 2 * ((itemv) & 3) + hh; LAS float* sd_ = (scd); float v = gpre; \
        _Pragma("unroll") for (int off = 1; off < 64; off <<= 1) { const float o = __shfl_up(v, off); if (lane >= off) v += o; } \
        const float glast = __shfl(v, 63); const float eg = __expf(v); \
        sd_[lane] = v; sd_[64 + lane] = bpre; sd_[128 + lane] = eg; sd_[192 + lane] = __expf(glast - v); sd_[256 + lane] = bpre * eg; \
        if (lane == 0) GT[Jg.cu * 8 + hg] = __expf(glast); } while (0)
    if ((int)blockIdx.x < NCU * 4) { GDN_PREFETCH((int)blockIdx.x); if (wq == 0) GDN_GATES(scb0, (int)blockIdx.x); }
#pragma unroll 1
    for (int item = blockIdx.x; item < NCU * 4; item += G) {
        const GdnItem I = gdn_item(item); const int hp = item & 3, h = 2 * hp + hh;
        LAS float* const sc = par ? scb1 : scb0;
        if (hp != cw_hp) {
            __syncthreads();
            for (int idx = tih; idx < 768; idx += 256) { const int j = idx / 192, cc = idx % 192; ((LAS float*)(hb + CW_OFF))[idx] = P.conv_w[j * 1536 + (cc >> 6) * 512 + h * 64 + (cc & 63)]; }
            cw_hp = hp;
            __syncthreads();
        }
#pragma unroll
        for (int k = 0; k < 7; ++k) { const int q = tih + 256 * k; if (q < 1608) *(LAS v4u*)(hb + RAW_OFF + q * 16) = pre[k]; }
        __syncthreads();
#ifdef PROBE_PREFIX
        if (!(P.flags & 256))
#endif
        {
            const int t = t1;
#pragma unroll
            for (int p = 0; p < 3; ++p) {
                float acc[16];
#pragma unroll
                for (int i = 0; i < 16; ++i) acc[i] = 0.f;
#pragma unroll
                for (int j = 0; j < 4; ++j) {
                    float rw[16];
                    { const LAS v4u* rp = (const LAS v4u*)(hb + RAW_OFF + (t + j) * 384 + (p * 64 + 16 * cg) * 2);
                      float f0[8], f1[8]; unpack8(rp[0], f0); unpack8(rp[1], f1);
#pragma unroll
                      for (int i = 0; i < 8; ++i) { rw[i] = f0[i]; rw[8 + i] = f1[i]; } }
                    const LAS float* cwj = (const LAS float*)(hb + CW_OFF) + j * 192 + p * 64 + 16 * cg;
#pragma unroll
                    for (int i4 = 0; i4 < 4; ++i4) { const f32x4 w = ((const LAS f32x4*)cwj)[i4];
                        acc[4 * i4] += rw[4 * i4] * w[0]; acc[4 * i4 + 1] += rw[4 * i4 + 1] * w[1]; acc[4 * i4 + 2] += rw[4 * i4 + 2] * w[2]; acc[4 * i4 + 3] += rw[4 * i4 + 3] * w[3]; }
                }
                float ss = 0.f;
#pragma unroll
                for (int i = 0; i < 16; ++i) { acc[i] = siluf(acc[i]); ss += acc[i] * acc[i]; }
                ss += __shfl_xor(ss, 1); ss += __shfl_xor(ss, 2);
                float scale = 1.f;
                if (p == 0) scale = 0.125f * __builtin_amdgcn_rsqf(ss + 1e-6f); else if (p == 1) scale = __builtin_amdgcn_rsqf(ss + 1e-6f);
                if (t >= I.L) scale = 0.f;
                v4u o0, o1;
                o0.x = pk2(acc[0] * scale, acc[1] * scale); o0.y = pk2(acc[2] * scale, acc[3] * scale); o0.z = pk2(acc[4] * scale, acc[5] * scale); o0.w = pk2(acc[6] * scale, acc[7] * scale);
                o1.x = pk2(acc[8] * scale, acc[9] * scale); o1.y = pk2(acc[10] * scale, acc[11] * scale); o1.z = pk2(acc[12] * scale, acc[13] * scale); o1.w = pk2(acc[14] * scale, acc[15] * scale);
                LAS v4u* dst = (LAS v4u*)(hb + p * 9216 + t * 144 + cg * 32);
                dst[0] = o0; dst[1] = o1;
            }
        }
        if (item + G < NCU * 4) GDN_PREFETCH(item + G);
        __syncthreads();
#ifdef PROBE_PREFIX
        if (!(P.flags & 512))
#endif
        {
            const int i = lane & 15, q4 = lane >> 4;
            const LAS unsigned char* kbp = hb + KB_OFF; const LAS unsigned char* qbp = hb + QB_OFF;
#pragma unroll
            for (int k3 = 0; k3 < 3; ++k3) {
                const int idx = wq + 4 * k3;
                if (idx < 10) {
                    const int rho = (idx >= 6) ? 3 : ((idx >= 3) ? 2 : ((idx >= 1) ? 1 : 0)), rp = idx - (rho * (rho + 1)) / 2;
                    bf16x8 ka[2], qa[2], kf[2];
#pragma unroll
                    for (int s2 = 0; s2 < 2; ++s2) { ka[s2] = *(const LAS bf16x8*)(kbp + (16 * rho + i) * 144 + 64 * s2 + 16 * q4); qa[s2] = *(const LAS bf16x8*)(qbp + (16 * rho + i) * 144 + 64 * s2 + 16 * q4);
                        kf[s2] = *(const LAS bf16x8*)(kbp + (16 * rp + i) * 144 + 64 * s2 + 16 * q4); }
                    f32x4 akk = z4, aqk = z4;
#pragma unroll
                    for (int s2 = 0; s2 < 2; ++s2) { akk = mfma16(ka[s2], kf[s2], akk); aqk = mfma16(qa[s2], kf[s2], aqk); }
                    const int tc = 16 * rp + i; const float gcol = sc[tc];
#pragma unroll
                    for (int r = 0; r < 4; ++r) { const int t = 16 * rho + 4 * q4 + r; const float dec = __expf(fminf(sc[t] - gcol, 0.f));
                        const float lv = (tc < t) ? sc[64 + t] * akk[r] * dec : 0.f; const float qv = (tc <= t) ? aqk[r] * dec : 0.f;
                        *(LAS float*)(hb + LM_OFF + t * 272 + tc * 4) = lv;
                        *(LAS unsigned short*)(hb + XQK_OFF + t * 144 + tc * 2) = (unsigned short)(pk2(qv, 0.f) & 0xffffu); }
                }
            }
#pragma unroll
            for (int rp = 1; rp < 4; ++rp) if (rp > wq) {
                const int tc = 16 * rp + i;
#pragma unroll
                for (int r = 0; r < 4; ++r) { const int t = 16 * wq + 4 * q4 + r; *(LAS unsigned short*)(hb + XQK_OFF + t * 144 + tc * 2) = 0; }
            }
        }
        __syncthreads();
        unsigned char* ops = P.ws + WS_OPS + ((size_t)I.cu * 8 + h) * OPS_UNIT;
#ifdef PROBE_PREFIX
        if (!(P.flags & 1024))
#endif
        if (wq == 0) {
            const int b = lane >> 4, c = lane & 15;
            float d[16];
#pragma unroll
            for (int i = 0; i < 16; ++i) {
                float a0 = (i == c) ? 1.f : 0.f;
#pragma unroll
                for (int k = 0; k < (i + 3) / 4; ++k) { const f32x4 l4 = *(const LAS f32x4*)(hb + LM_OFF + (16 * b + i) * 272 + (16 * b + 4 * k) * 4);
#pragma unroll
                    for (int e = 0; e < 4; ++e) if (4 * k + e < i) a0 -= l4[e] * d[4 * k + e]; }
                d[i] = a0;
            }
#pragma unroll
            for (int i = 0; i < 16; ++i) *(LAS float*)(hb + DI_OFF + ((b * 16 + i) * 16 + c) * 4) = d[i];
            if (item + G < NCU * 4) GDN_GATES(par ? scb0 : scb1, item + G);
        } else {
            const int i = lane & 15, q4 = lane >> 4, kind = wq - 1;
#pragma unroll 4
            for (int fr = 0; fr < 8; ++fr) {
                const int rho = fr >> 1, s2 = fr & 1, row = 16 * rho + i;
                v4u o; unsigned char* dst; int frp = fr;
                if (kind == 0) { const v2u lo = *(const LAS v2u*)(hb + XQK_OFF + row * 144 + (32 * s2 + 4 * q4) * 2), hi = *(const LAS v2u*)(hb + XQK_OFF + row * 144 + (32 * s2 + 16 + 4 * q4) * 2);
                    o.x = lo.x; o.y = lo.y; o.z = hi.x; o.w = hi.y; dst = ops + OPS_QK;
                    frp = (fr == 0) ? 0 : (fr == 2) ? 1 : (fr >= 4) ? fr - 2 : (fr == 1 ? 6 : 7); }
                else if (kind == 1) { const v2u lo = *(const LAS v2u*)(hb + QB_OFF + row * 144 + (32 * s2 + 4 * q4) * 2), hi = *(const LAS v2u*)(hb + QB_OFF + row * 144 + (32 * s2 + 16 + 4 * q4) * 2);
                    const float e = sc[128 + row];
                    o.x = pk2(bflo(lo.x) * e, bfhi(lo.x) * e); o.y = pk2(bflo(lo.y) * e, bfhi(lo.y) * e); o.z = pk2(bflo(hi.x) * e, bfhi(hi.x) * e); o.w = pk2(bflo(hi.y) * e, bfhi(hi.y) * e); dst = ops + OPS_QD; }
                else { float vv[8];
#pragma unroll
                    for (int e = 0; e < 8; ++e) { const int t = 32 * s2 + 16 * (e >> 2) + 4 * q4 + (e & 3); vv[e] = bf1(*(const LAS unsigned short*)(hb + KB_OFF + t * 144 + (16 * rho + i) * 2)) * sc[192 + t]; }
                    o = packf8(vv); dst = ops + OPS_KT; }
                *(v4u*)(dst + (frp * 64 + lane) * 16) = o;
            }
        }
        __syncthreads();
#ifdef PROBE_PREFIX
        if (!(P.flags & 2048))
#endif
        {
            const int l15 = lane & 15, q4 = lane >> 4;
            const LAS unsigned char* src = hb + (wq < 2 ? VB_OFF : KB_OFF); const LAS float* scl = sc + (wq < 2 ? 64 : 256);
            f32x4 X[4][2];
#pragma unroll
            for (int b = 0; b < 4; ++b) {
                f32x4 acc[2];
#pragma unroll
                for (int ct = 0; ct < 2; ++ct) { const int col = 32 * (wq & 1) + 16 * ct + l15;
#pragma unroll
                    for (int r = 0; r < 4; ++r) { const int t = 16 * b + 4 * q4 + r; acc[ct][r] = bf1(*(const LAS unsigned short*)(src + t * 144 + col * 2)) * scl[t]; } }
#pragma unroll
                for (int pr = 0; pr < 2; ++pr) {
                    const int m0 = 2 * pr, m1 = 2 * pr + 1;
                    if (m0 < b) {
                        f32x4 l0 = *(const LAS f32x4*)(hb + LM_OFF + (16 * b + l15) * 272 + (16 * m0 + 4 * q4) * 4), l1 = z4;
                        if (m1 < b) l1 = *(const LAS f32x4*)(hb + LM_OFF + (16 * b + l15) * 272 + (16 * m1 + 4 * q4) * 4);
                        const bf16x8 An = pack8(-l0, -l1);
#pragma unroll
                        for (int ct = 0; ct < 2; ++ct) acc[ct] = mfma16(An, pack8(X[m0][ct], (m1 < b) ? X[m1][ct] : z4), acc[ct]);
                    }
                }
                const f32x4 dv = *(const LAS f32x4*)(hb + DI_OFF + ((b * 16 + l15) * 16 + 4 * q4) * 4);
                const bf16x8 Dn = pack8(dv, z4);
#pragma unroll
                for (int ct = 0; ct < 2; ++ct) X[b][ct] = mfma16(Dn, pack8(acc[ct], z4), z4);
            }
            if (wq < 2) {
#pragma unroll
                for (int b = 0; b < 4; ++b)
#pragma unroll
                    for (int ct = 0; ct < 2; ++ct) { const int slice = 2 * (wq & 1) + ct; v2u o; o.x = pk2(X[b][ct][0], X[b][ct][1]); o.y = pk2(X[b][ct][2], X[b][ct][3]);
                        *(v2u*)(ops + OPS_U + ((slice * 4 + b) * 64 + lane) * 8) = o; }
            } else {
#pragma unroll
                for (int b = 0; b < 4; ++b)
#pragma unroll
                    for (int ct = 0; ct < 2; ++ct) { const int col = 32 * (wq & 1) + 16 * ct + l15;
#pragma unroll
                        for (int r = 0; r < 4; ++r) *(LAS unsigned short*)(hb + XW_OFF + (16 * b + 4 * q4 + r) * 144 + col * 2) = (unsigned short)(pk2(X[b][ct][r], 0.f) & 0xffffu); }
            }
        }
        __syncthreads();
        {
            const int i = lane & 15, q4 = lane >> 4;
#pragma unroll
            for (int ff = 0; ff < 2; ++ff) { const int fr = wq * 2 + ff, rho = fr >> 1, s2 = fr & 1, row = 16 * rho + i;
                const v2u lo = *(const LAS v2u*)(hb + XW_OFF + row * 144 + (32 * s2 + 4 * q4) * 2), hi = *(const LAS v2u*)(hb + XW_OFF + row * 144 + (32 * s2 + 16 + 4 * q4) * 2);
                v4u o; o.x = lo.x; o.y = lo.y; o.z = hi.x; o.w = hi.y;
                *(v4u*)(ops + OPS_W + (fr * 64 + lane) * 16) = o; }
        }
        __syncthreads();
        par ^= 1;
    }
#undef GDN_GATES
#undef GDN_PREFETCH
}
__device__ __forceinline__ v4u xchg8x8(LAS unsigned char* xs, int lane, v4u w) {
    *(LAS v4u*)(xs + (lane >> 3) * 144 + (lane & 7) * 16) = w;
    return *(const LAS v4u*)(xs + (lane & 7) * 144 + (lane >> 3) * 16);
}
__device__ __forceinline__ void bprep_item(const Params& P, LAS unsigned char* lds, int item, int tid, int lane, int wave) {
    int mode, s, c = 0, pi = 0;
    if (item < 1024) { mode = 0; s = item >> 7; c = item & 127; } else if (item < NCU) { mode = 1; s = item - 1024; } else { mode = 2; s = (item - NCU) >> 3; pi = (item - NCU) & 7; }
    const int tl = tid >> 3, part = tid & 7, kk = part >> 1, hh2 = part & 1, l31 = tl & 31;
    const bf16* QKVB = (const bf16*)(P.ws + WS_QKVB);
    unsigned char* yscr = (unsigned char*)P.out;
    const bool valid = (mode == 1) ? (tl < 16) : true;
    const long m = (mode == 0) ? (long)s * TP + c * 64 + tl : (long)MP + s * 16 + tl;
    size_t kvblk, qblk = 0; unsigned char *kdst, *vdst, *qdst = nullptr;
    if (mode == 0) { kvblk = (size_t)(m >> 5); qblk = kvblk; kdst = yscr + YO_KF; vdst = yscr + YO_VF; qdst = P.ws + WS_QF; }
    else if (mode == 1) { kvblk = (size_t)s * 18 + 16 + (tl >> 5); qblk = (size_t)s * 2 + (tl >> 5); kdst = P.ws + WS_KFS; vdst = P.ws + WS_VFS; qdst = P.ws + WS_QFS; }
    else { kvblk = (size_t)s * 18 + 2 * pi + (tl >> 5); kdst = P.ws + WS_KFS; vdst = P.ws + WS_VFS; }
    const int pp = lane >> 3, tp = lane & 7;
    const size_t piece = (size_t)(pp >> 1) * 1024 + (size_t)((pp & 1) * 32 + ((8 * wave + tp) & 31)) * 16;
    LAS unsigned char* xs = lds + 81920 + wave * 1152;
    float qg[8], kg[8];
#pragma unroll
    for (int i = 0; i < 8; ++i) { qg[i] = P.qn_g[8 * part + i]; kg[i] = P.kn_g[8 * part + i]; }
#pragma unroll 1
    for (int hb4 = 0; hb4 < 8; hb4 += 4) {
        v4u wq_[4], wk_[4], wv_[4]; f32x4 ck_[4][2], cv_[4][2];
#pragma unroll
        for (int hi = 0; hi < 4; ++hi) { const int h = hb4 + hi;
            if (mode != 2) { wq_[hi] = wk_[hi] = wv_[hi] = (v4u){0u, 0u, 0u, 0u};
                if (valid) { const bf16* rp = QKVB + (size_t)m * 1536 + h * 64 + 8 * part; wq_[hi] = *(const v4u*)rp; wk_[hi] = *(const v4u*)(rp + 512); wv_[hi] = *(const v4u*)(rp + 1024); } }
            else { const size_t co = (((size_t)s * 512 + 64 * pi + tl) * 8 + h) * 64 + 8 * part;
                ck_[hi][0] = ((const f32x4*)(P.cache_k + co))[0]; ck_[hi][1] = ((const f32x4*)(P.cache_k + co))[1]; cv_[hi][0] = ((const f32x4*)(P.cache_v + co))[0]; cv_[hi][1] = ((const f32x4*)(P.cache_v + co))[1]; } }
#pragma unroll
        for (int hi = 0; hi < 4; ++hi) { const int h = hb4 + hi;
            float f[8];
            if (mode != 2) {
                unpack8(wq_[hi], f); float ss = 0.f;
#pragma unroll
                for (int i = 0; i < 8; ++i) ss += f[i] * f[i];
                ss += __shfl_xor(ss, 1); ss += __shfl_xor(ss, 2); ss += __shfl_xor(ss, 4);
                float rstd = __builtin_amdgcn_rsqf(ss * (1.0f / 64.0f) + 1e-6f);
#pragma unroll
                for (int i = 0; i < 8; ++i) f[i] = f[i] * (rstd * 0.18033688011f) * qg[i];
                *(v4u*)(qdst + (qblk * 8 + h) * 4096 + piece) = xchg8x8(xs, lane, packf8(f));
                unpack8(wk_[hi], f); ss = 0.f;
#pragma unroll
                for (int i = 0; i < 8; ++i) ss += f[i] * f[i];
                ss += __shfl_xor(ss, 1); ss += __shfl_xor(ss, 2); ss += __shfl_xor(ss, 4);
                rstd = __builtin_amdgcn_rsqf(ss * (1.0f / 64.0f) + 1e-6f);
#pragma unroll
                for (int i = 0; i < 8; ++i) f[i] = f[i] * rstd * kg[i];
            } else { f[0] = ck_[hi][0][0]; f[1] = ck_[hi][0][1]; f[2] = ck_[hi][0][2]; f[3] = ck_[hi][0][3]; f[4] = ck_[hi][1][0]; f[5] = ck_[hi][1][1]; f[6] = ck_[hi][1][2]; f[7] = ck_[hi][1][3]; }
            *(v4u*)(kdst + (kvblk * 8 + h) * 4096 + piece) = xchg8x8(xs, lane, packf8(f));
            {
                float* ko = nullptr;
                if (mode == 0) { const int ts = c * 64 + tl; if (ts >= TP - 512) ko = P.out + O_KP + (((size_t)s * 512 + (ts - (TP - 512))) * 8 + h) * 64 + 8 * part; }
                else if (mode == 1 && valid) ko = P.out + O_KS + (((size_t)s * 16 + tl) * 8 + h) * 64 + 8 * part;
                if (ko) { ((f32x4*)ko)[0] = (f32x4){f[0], f[1], f[2], f[3]}; ((f32x4*)ko)[1] = (f32x4){f[4], f[5], f[6], f[7]}; }
            }
            if (mode != 2) unpack8(wv_[hi], f);
            else { f[0] = cv_[hi][0][0]; f[1] = cv_[hi][0][1]; f[2] = cv_[hi][0][2]; f[3] = cv_[hi][0][3]; f[4] = cv_[hi][1][0]; f[5] = cv_[hi][1][1]; f[6] = cv_[hi][1][2]; f[7] = cv_[hi][1][3]; }
            {
                float* vo = nullptr;
                if (mode == 0) { const int ts = c * 64 + tl; if (ts >= TP - 512) vo = P.out + O_VP + (((size_t)s * 512 + (ts - (TP - 512))) * 8 + h) * 64 + 8 * part; }
                else if (mode == 1 && valid) vo = P.out + O_VS + (((size_t)s * 16 + tl) * 8 + h) * 64 + 8 * part;
                if (vo) { ((f32x4*)vo)[0] = (f32x4){f[0], f[1], f[2], f[3]}; ((f32x4*)vo)[1] = (f32x4){f[4], f[5], f[6], f[7]}; }
            }
            *(LAS v4u*)(lds + (h * 64 + tl) * 144 + part * 16) = packf8(f);
        }
    }
    __syncthreads();
    {
        const size_t blk0 = (mode == 0) ? (size_t)((s * TP + c * 64) >> 5) : (mode == 1 ? (size_t)s * 18 + 16 : (size_t)s * 18 + 2 * pi);
        const int l31v = lane & 31, hhv = lane >> 5;
#pragma unroll 1
        for (int it = 0; it < 8; ++it) {
            const int frag = it * 8 + wave, s2 = frag & 1, dt = (frag >> 1) & 1, h = (frag >> 2) & 7, blkl = frag >> 5;
            float vv[8];
#pragma unroll
            for (int e = 0; e < 8; ++e) { const int key = 32 * blkl + 16 * s2 + 8 * (e >> 2) + 4 * hhv + (e & 3);
                vv[e] = bf1(*(const LAS unsigned short*)(lds + (h * 64 + key) * 144 + (32 * dt + l31v) * 2)); }
            *(v4u*)(vdst + ((blk0 + blkl) * 8 + h) * 4096 + (size_t)(dt * 2 + s2) * 1024 + lane * 16) = packf8(vv);
        }
    }
    __syncthreads();
}
__device__ __forceinline__ void conv_state_out(const Params& P, int tid, int G) {
    const bf16* QKVA = (const bf16*)(P.ws + WS_QKVA);
    for (int idx = blockIdx.x * 512 + tid; idx < 24 * 3 * 1536; idx += G * 512) {
        const int col = idx % 1536, j = (idx / 1536) % 3, sq = idx / (3 * 1536);
        if (sq < 8) P.out[O_CP + ((size_t)sq * 3 + j) * 1536 + col] = bf1(QKVA[((size_t)sq * TP + TP - 3 + j) * 1536 + col]);
        else { const int s = sq - 8; P.out[O_CS + ((size_t)s * 3 + j) * 1536 + col] = bf1(QKVA[((size_t)MP + s * 16 + 13 + j) * 1536 + col]); }
    }
}
__device__ __forceinline__ void scan_chain(const Params& P, bool smp, int s, int h, int sl, int lane) {
    const int l15 = lane & 15, q4 = lane >> 4, e = 16 * sl + l15;
    const int cu0 = smp ? 1024 + s : s * 128, nsteps = smp ? 1 : 128;
    f32x4 S[4];
#pragma unroll
    for (int tau = 0; tau < 4; ++tau)
#pragma unroll
        for (int r = 0; r < 4; ++r) S[tau][r] = smp ? P.state_gdn[(((size_t)s * 8 + h) * 64 + 16 * tau + 4 * q4 + r) * 64 + e] : 0.f;
    const float* GT = (const float*)(P.ws + WS_GT);
    float* OA = (float*)((unsigned char*)P.out + YO_OA); float* OAS = (float*)(P.ws + WS_OAS);
#pragma unroll 1
    for (int n = 0; n < nsteps; ++n) {
        const int cu = cu0 + n; const unsigned char* ops = P.ws + WS_OPS + ((size_t)cu * 8 + h) * OPS_UNIT;
        const float gt = GT[cu * 8 + h];
        const bf16x8* Wf = (const bf16x8*)(ops + OPS_W) + lane; const bf16x8* KT = (const bf16x8*)(ops + OPS_KT) + lane;
        const bf16x8* QD = (const bf16x8*)(ops + OPS_QD) + lane; const bf16x8* QK = (const bf16x8*)(ops + OPS_QK) + lane;
        const v2u* Up = (const v2u*)(ops + OPS_U) + (sl * 4) * 64 + lane;
        bf16x8 Sb[2]; Sb[0] = pack8(S[0], S[1]); Sb[1] = pack8(S[2], S[3]);
        f32x4 vn[4];
#pragma unroll
        for (int tau = 0; tau < 4; ++tau) { f32x4 av = {0.f, 0.f, 0.f, 0.f}; av = mfma16(Wf[(2 * tau) * 64], Sb[0], av); av = mfma16(Wf[(2 * tau + 1) * 64], Sb[1], av);
            const v2u ub = Up[tau * 64]; const f32x4 u = {bflo(ub.x), bfhi(ub.x), bflo(ub.y), bfhi(ub.y)}; vn[tau] = u - av; }
        bf16x8 Vb[2]; Vb[0] = pack8(vn[0], vn[1]); Vb[1] = pack8(vn[2], vn[3]);
        f32x4 ao[4];
#pragma unroll
        for (int tau = 0; tau < 4; ++tau) { f32x4 a = {0.f, 0.f, 0.f, 0.f}; a = mfma16(QD[(2 * tau) * 64], Sb[0], a); a = mfma16(QD[(2 * tau + 1) * 64], Sb[1], a);
            a = mfma16(QK[((tau < 2) ? tau : 2 * tau - 2) * 64], Vb[0], a); if (tau >= 2) a = mfma16(QK[(2 * tau - 1) * 64], Vb[1], a); ao[tau] = a; }
#pragma unroll
        for (int tau = 0; tau < 4; ++tau) { f32x4 a = S[tau] * gt; a = mfma16(KT[(2 * tau) * 64], Vb[0], a); a = mfma16(KT[(2 * tau + 1) * 64], Vb[1], a); S[tau] = a; }
        if (!smp) { float* op = OA + ((size_t)s * TP + n * 64) * 512 + h * 64 + e;
#pragma unroll
            for (int tau = 0; tau < 4; ++tau)
#pragma unroll
                for (int r = 0; r < 4; ++r) op[(size_t)(16 * tau + 4 * q4 + r) * 512] = ao[tau][r];
        } else { float* op = OAS + ((size_t)s * 16) * 512 + h * 64 + e;
#pragma unroll
            for (int r = 0; r < 4; ++r) op[(size_t)(4 * q4 + r) * 512] = ao[0][r]; }
    }
    float* so = P.out + (smp ? O_GS : O_GP) + (((size_t)s * 8 + h) * 64) * 64 + e;
#pragma unroll
    for (int tau = 0; tau < 4; ++tau)
#pragma unroll
        for (int r = 0; r < 4; ++r) so[(size_t)(16 * tau + 4 * q4 + r) * 64] = S[tau][r];
}
constexpr int SR_SLOT = 30720, SR_NS = 4, OT_A = 122880, OT_B = 131584, ZT_OFF = 139776;
__device__ __forceinline__ void scan_prompt_wg(const Params& P, LAS unsigned char* lds, int s, int h, int wave, int lane) {
    constexpr int NST = 128;
    const unsigned char* ops0 = P.ws + WS_OPS + ((size_t)(s * 128) * 8 + h) * OPS_UNIT;
    const size_t step_stride = (size_t)8 * OPS_UNIT;
#define SCAN_BAR() do { asm volatile("" ::: "memory"); __builtin_amdgcn_s_barrier(); asm volatile("" ::: "memory"); } while (0)
    if (wave >= 4) {
        const int lw = wave - 4;
        const int np = (lw < 2) ? 8 : 7, p0 = (lw < 2) ? 8 * lw : 16 + 7 * (lw - 2);
        const unsigned char* src = ops0 + (size_t)p0 * 1024 + lane * 16;
#define SCAN_ISSUE(n, slot) do { const unsigned char* s_ = src + (size_t)(n) * step_stride; LAS unsigned char* d_ = lds + (slot) * SR_SLOT + p0 * 1024; \
        _Pragma("unroll") for (int i_ = 0; i_ < 7; ++i_) glds16_asm(s_ + i_ * 1024, d_ + i_ * 1024, true  ); \
        if (lw < 2) glds16_asm(s_ + 7 * 1024, d_ + 7 * 1024, true); } while (0)
        const int ftid = lw * 64 + lane, ft = ftid >> 2, fp = ftid & 3;
        float gg[16];
#pragma unroll
        for (int i = 0; i < 16; ++i) gg[i] = P.gdn_g[16 * fp + i];
        bf16* Mr = (bf16*)(P.ws + WS_MIX) + ((size_t)s * TP + ft) * 1024 + h * 64 + 16 * fp;
        const unsigned char* zsrc = (const unsigned char*)((const bf16*)(P.ws + WS_Z) + ((size_t)s * TP + 16 * lw + (lane >> 3)) * 1024 + h * 64) + (lane & 7) * 16;
#define SCAN_ZISSUE(n) do { const unsigned char* z_ = zsrc + (size_t)(n) * 64 * 2048; LAS unsigned char* d_ = lds + ZT_OFF + ((n) & 1) * 8192 + (2 * lw) * 1024; \
        glds16_asm(z_, d_, false); glds16_asm(z_ + 8 * 2048, d_ + 1024, false); } while (0)
#pragma unroll
        for (int i = 0; i < 16; ++i) asm volatile("" : "+v"(gg[i]));
        SCAN_ZISSUE(0);
        SCAN_ISSUE(0, 0); SCAN_ISSUE(1, 1); SCAN_ISSUE(2, 2);
        if (lw < 2) asm volatile("s_waitcnt vmcnt(16)" ::: "memory"); else asm volatile("s_waitcnt vmcnt(14)" ::: "memory");
        SCAN_BAR();
        int slot = 3;
#pragma unroll 1
        for (int n = 0; n <= NST; ++n) {
            if (n >= 1) {
                const LAS unsigned char* ot = lds + (((n - 1) & 1) ? OT_B : OT_A) + ft * 128 + fp * 32;
                const LAS unsigned char* zt = lds + ZT_OFF + ((n - 1) & 1) * 8192 + ft * 128 + fp * 32;
                float o[16], zf[16]; { float t0[8], t1[8]; unpack8(*(const LAS v4u*)ot, t0); unpack8(*(const LAS v4u*)(ot + 16), t1);
#pragma unroll
                    for (int i = 0; i < 8; ++i) { o[i] = t0[i]; o[8 + i] = t1[i]; }
                    unpack8(*(const LAS v4u*)zt, t0); unpack8(*(const LAS v4u*)(zt + 16), t1);
#pragma unroll
                    for (int i = 0; i < 8; ++i) { zf[i] = t0[i]; zf[8 + i] = t1[i]; } }
                float ss = 0.f;
#pragma unroll
                for (int i = 0; i < 16; ++i) ss += o[i] * o[i];
                ss += __shfl_xor(ss, 1); ss += __shfl_xor(ss, 2);
                const float rstd = __builtin_amdgcn_rsqf(ss * (1.0f / 64.0f) + 1e-6f);
                float r[16];
#pragma unroll
                for (int i = 0; i < 16; ++i) r[i] = o[i] * rstd * gg[i] * siluf(zf[i]);
                bf16* mp = Mr + (size_t)(n - 1) * 64 * 1024;
                v4u w0, w1; w0.x = pk2(r[0], r[1]); w0.y = pk2(r[2], r[3]); w0.z = pk2(r[4], r[5]); w0.w = pk2(r[6], r[7]); w1.x = pk2(r[8], r[9]); w1.y = pk2(r[10], r[11]); w1.z = pk2(r[12], r[13]); w1.w = pk2(r[14], r[15]);
                *(v4u*)mp = w0; *(v4u*)(mp + 8) = w1;
            }
            if (n < NST) {
                asm volatile("s_waitcnt lgkmcnt(0)" ::: "memory");
                if (n + 1 < NST) SCAN_ZISSUE(n + 1);
                if (n + 3 < NST) SCAN_ISSUE(n + 3, slot);
                if (n >= 2 && n + 3 < NST) { if (lw < 2) asm volatile("s_waitcnt vmcnt(20)" ::: "memory"); else asm volatile("s_waitcnt vmcnt(18)" ::: "memory"); }
                else asm volatile("s_waitcnt vmcnt(0)" ::: "memory");
                slot = (slot == SR_NS - 1) ? 0 : slot + 1;
                SCAN_BAR();
            }
        }
#undef SCAN_ZISSUE
#undef SCAN_ISSUE
    } else {
        const int sl = wave, l15 = lane & 15, q4 = lane >> 4, e = 16 * sl + l15;
        f32x4 S[4];
#pragma unroll
        for (int tau = 0; tau < 4; ++tau) S[tau] = (f32x4){0.f, 0.f, 0.f, 0.f};
        const float* GT = (const float*)(P.ws + WS_GT) + (size_t)(s * 128) * 8 + h;
        const v2u* Ug = (const v2u*)(ops0 + OPS_U) + (sl * 4) * 64 + lane;
        v2u ua[4], ub[4];
#pragma unroll
        for (int tau = 0; tau < 4; ++tau) { ua[tau] = Ug[tau * 64]; ub[tau] = (Ug + step_stride / 8)[tau * 64]; }
        SCAN_BAR();
        int slot = 0;
        float gt = GT[0];
#pragma unroll 1
        for (int n = 0; n < NST; ++n) {
            const LAS unsigned char* ops = lds + slot * SR_SLOT;
            const float gtn = (n + 1 < NST) ? GT[(size_t)(n + 1) * 8] : 0.f;
            v2u uc[4];
#pragma unroll
            for (int tau = 0; tau < 4; ++tau) uc[tau] = (n + 2 < NST) ? (Ug + (size_t)(n + 2) * (step_stride / 8))[tau * 64] : (v2u){0u, 0u};
            const LAS bf16x8* Wf = (const LAS bf16x8*)(ops + OPS_W) + lane; const LAS bf16x8* KT = (const LAS bf16x8*)(ops + OPS_KT) + lane;
            const LAS bf16x8* QD = (const LAS bf16x8*)(ops + OPS_QD) + lane; const LAS bf16x8* QK = (const LAS bf16x8*)(ops + OPS_QK) + lane;
            bf16x8 wv[8], qdv[8], qkv[6], ktv[8];
#pragma unroll
            for (int i = 0; i < 8; ++i) wv[i] = Wf[i * 64];
#pragma unroll
            for (int i = 0; i < 8; ++i) qdv[i] = QD[i * 64];
#pragma unroll
            for (int i = 0; i < 6; ++i) qkv[i] = QK[i * 64];
#pragma unroll
            for (int i = 0; i < 8; ++i) ktv[i] = KT[i * 64];
            __builtin_amdgcn_sched_barrier(0);
            bf16x8 Sb[2]; Sb[0] = pack8(S[0], S[1]); Sb[1] = pack8(S[2], S[3]);
            f32x4 vn[4];
#pragma unroll
            for (int tau = 0; tau < 4; ++tau) { f32x4 av = {0.f, 0.f, 0.f, 0.f}; av = mfma16(wv[2 * tau], Sb[0], av); av = mfma16(wv[2 * tau + 1], Sb[1], av);
                const f32x4 u = {bflo(ua[tau].x), bfhi(ua[tau].x), bflo(ua[tau].y), bfhi(ua[tau].y)}; vn[tau] = u - av; }
            bf16x8 Vb[2]; Vb[0] = pack8(vn[0], vn[1]); Vb[1] = pack8(vn[2], vn[3]);
            f32x4 ao[4];
#pragma unroll
            for (int tau = 0; tau < 4; ++tau) { f32x4 a = {0.f, 0.f, 0.f, 0.f}; a = mfma16(qdv[2 * tau], Sb[0], a); a = mfma16(qdv[2 * tau + 1], Sb[1], a);
                a = mfma16(qkv[(tau < 2) ? tau : 2 * tau - 2], Vb[0], a); if (tau >= 2) a = mfma16(qkv[2 * tau - 1], Vb[1], a); ao[tau] = a; }
#pragma unroll
            for (int tau = 0; tau < 4; ++tau) { f32x4 a = S[tau] * gt; a = mfma16(ktv[2 * tau], Vb[0], a); a = mfma16(ktv[2 * tau + 1], Vb[1], a); S[tau] = a; }
            LAS unsigned char* ot = lds + ((n & 1) ? OT_B : OT_A) + e * 2;
#pragma unroll
            for (int tau = 0; tau < 4; ++tau)
#pragma unroll
                for (int r = 0; r < 4; ++r) *(LAS unsigned short*)(ot + (16 * tau + 4 * q4 + r) * 128) = (unsigned short)(pk2(ao[tau][r], 0.f) & 0xffffu);
            gt = gtn;
#pragma unroll
            for (int tau = 0; tau < 4; ++tau) { ua[tau] = ub[tau]; ub[tau] = uc[tau]; }
            slot = (slot == SR_NS - 1) ? 0 : slot + 1;
            asm volatile("s_waitcnt lgkmcnt(0)" ::: "memory");
            SCAN_BAR();
        }
        float* so = P.out + O_GP + (((size_t)s * 8 + h) * 64) * 64 + e;
#pragma unroll
        for (int tau = 0; tau < 4; ++tau)
#pragma unroll
            for (int r = 0; r < 4; ++r) so[(size_t)(16 * tau + 4 * q4 + r) * 64] = S[tau][r];
    }
#undef SCAN_BAR
}
#ifdef PROBE_PREFIX
#define PROBE_NOEXP (P.flags & 4096)
#define PROBE_NOPV (P.flags & 8192)
#else
#define PROBE_NOEXP 0
#define PROBE_NOPV 0
#endif
constexpr int TAB_LD = 704, TAB_OFF = 131584;
__device__ __forceinline__ float wave_max(float v) {
#pragma unroll
    for (int o = 1; o < 64; o <<= 1) v = fmaxf(v, __shfl_xor(v, o));
    return v;
}
__device__ __forceinline__ void attn_setup(const Params& P, LAS unsigned char* lds, int tid) {
    LAS float* tab = (LAS float*)(lds + TAB_OFF); LAS float* mh = tab + 8 * TAB_LD;
    const int lane = tid & 63, h = tid >> 6;
    const float gq = wave_max(fabsf(P.qn_g[lane])), gk = wave_max(fabsf(P.kn_g[lane]));
    float tb = -1e30f;
    for (int i = lane; i < 257; i += 64) tb = fmaxf(tb, P.rel_bias[h * 257 + i]);
    tb = wave_max(tb);
    if (lane == 0) mh[h] = 8.0f * gq * gk + tb;
    __syncthreads();
    { float tv[11];
#pragma unroll
      for (int k = 0; k < 11; ++k) { const int idx = tid + 512 * k, hh = idx / TAB_LD, r = idx - hh * TAB_LD; tv[k] = P.rel_bias[hh * 257 + (r > 256 ? 256 : r)]; }
#pragma unroll
      for (int k = 0; k < 11; ++k) { const int idx = tid + 512 * k, hh = idx / TAB_LD; tab[idx] = (tv[k] - mh[hh]) * 1.44269504089f; } }
    __syncthreads();
}
__device__ __forceinline__ void attn_unit(const Params& P, const LAS float* tabh, LAS unsigned char* ring, int cu, int h, int lane) {
    const bool smp = cu >= 1024; const int s = smp ? cu - 1024 : cu >> 7; const int c = smp ? 0 : cu & 127;
    const int l31 = lane & 31, hh = lane >> 5;
    const unsigned char* yscr = (const unsigned char*)P.out;
    const unsigned char* qb_ = smp ? P.ws + WS_QFS + ((size_t)(s * 2) * 8 + h) * 4096 : P.ws + WS_QF + ((size_t)(s * 256 + 2 * c) * 8 + h) * 4096;
    const long kblk0 = smp ? (long)s * 18 : (long)s * 256 + 2 * (c - 8);
    const unsigned char* kb_ = (smp ? P.ws + WS_KFS : yscr + YO_KF) + h * 4096;
    const unsigned char* vb_ = (smp ? P.ws + WS_VFS : yscr + YO_VF) + h * 4096;
    bf16x8 qf[2][4];
#pragma unroll
    for (int qb = 0; qb < 2; ++qb)
#pragma unroll
        for (int kk = 0; kk < 4; ++kk) qf[qb][kk] = *(const bf16x8*)(qb_ + (size_t)qb * 32768 + kk * 1024 + lane * 16);
    f32x16 oacc[2][2]; float lsum[2] = {0.f, 0.f};
#pragma unroll
    for (int qb = 0; qb < 2; ++qb)
#pragma unroll
        for (int dt = 0; dt < 2; ++dt)
#pragma unroll
            for (int r = 0; r < 16; ++r) oacc[qb][dt][r] = 0.f;
    const int j_lo = smp ? 0 : (c < 8 ? 2 * (8 - c) : 0), j_hi = smp ? 17 : 18;
    f32x16 cbias;
    { const float bconst = tabh[256];
#pragma unroll
      for (int r = 0; r < 16; ++r) cbias[r] = bconst; }
#define ATT_DMA(jj, sl) do { const unsigned char* kp_ = kb_ + (size_t)(kblk0 + (jj)) * 32768 + lane * 16; const unsigned char* vp_ = vb_ + (size_t)(kblk0 + (jj)) * 32768 + lane * 16; \
        LAS unsigned char* d_ = ring + (sl) * 8192; \
        _Pragma("unroll") for (int kk = 0; kk < 4; ++kk) glds16_asm(kp_ + kk * 1024, d_ + kk * 1024, false); \
        _Pragma("unroll") for (int kk = 0; kk < 4; ++kk) glds16_asm(vp_ + kk * 1024, d_ + 4096 + kk * 1024, false); } while (0)
#define ATT_ZDMA(sl) do { int ln_ = lane; asm volatile("" : "+v"(ln_));     \
        const int tk_ = ln_ >> 3, ch_ = (ln_ & 7) ^ tk_; LAS unsigned char* d_ = ring + (sl) * 8192; \
        _Pragma("unroll") for (int p_ = 0; p_ < 8; ++p_) { const int tok_ = smp ? ((8 * p_ + tk_) & 15) : (8 * p_ + tk_); \
            glds16_asm(zbase + (size_t)tok_ * 2048 + ch_ * 16, d_ + p_ * 1024, false); } } while (0)
#define ATT_BODY(KF, VF, jj) do { const int kt = (jj) >> 1, half = (jj) & 1; \
        _Pragma("unroll") for (int qb = 0; qb < 2; ++qb) { \
            f32x16 sa; \
            if (kt <= 5) { sa = mfma32(KF[0], qf[qb][0], cbias); } \
            else { const LAS float* tp_ = tabh + (512 - 64 * kt - 32 * half + 32 * qb + l31 - 4 * hh + 128 - 27); f32x16 bi; \
                _Pragma("unroll") for (int r = 0; r < 16; ++r) bi[r] = tp_[27 - ((r & 3) + 8 * (r >> 2))]; \
                sa = mfma32(KF[0], qf[qb][0], bi); } \
            _Pragma("unroll") for (int kk = 1; kk < 4; ++kk) sa = mfma32(KF[kk], qf[qb][kk], sa); \
            float p[16]; \
            _Pragma("unroll") for (int r = 0; r < 16; ++r) p[r] = PROBE_NOEXP ? sa[r] : __builtin_amdgcn_exp2f(sa[r]); \
            if (smp && (jj) == 16) { \
                _Pragma("unroll") for (int r = 8; r < 16; ++r) p[r] = 0.f; \
            } \
            { typedef float f32x2_ __attribute__((ext_vector_type(2))); f32x2_ a2 = {p[0], p[1]}, b2 = {p[2], p[3]}; \
              _Pragma("unroll") for (int r = 4; r < 16; r += 4) { a2 += (f32x2_){p[r], p[r + 1]}; b2 += (f32x2_){p[r + 2], p[r + 3]}; } \
              a2 += b2; lsum[qb] += a2.x + a2.y; } \
            v4u w0, w1; w0.x = pk2(p[0], p[1]); w0.y = pk2(p[2], p[3]); w0.z = pk2(p[4], p[5]); w0.w = pk2(p[6], p[7]); w1.x = pk2(p[8], p[9]); w1.y = pk2(p[10], p[11]); w1.z = pk2(p[12], p[13]); w1.w = pk2(p[14], p[15]); \
            const bf16x8 pb0 = __builtin_bit_cast(bf16x8, w0), pb1 = __builtin_bit_cast(bf16x8, w1); \
            if (PROBE_NOPV) { asm volatile("" :: "v"(pb0), "v"(pb1)); } else { \
            _Pragma("unroll") for (int dt = 0; dt < 2; ++dt) { oacc[qb][dt] = mfma32(VF[dt * 2 + 0], pb0, oacc[qb][dt]); oacc[qb][dt] = mfma32(VF[dt * 2 + 1], pb1, oacc[qb][dt]); } } \
        } } while (0)
    int zsl = 0;
    const size_t m0u = smp ? (size_t)MP + s * 16 : (size_t)s * TP + c * 64;
    const unsigned char* zbase = (const unsigned char*)((const bf16*)(P.ws + WS_Z) + m0u * 1024 + 512 + h * 64);
    {
#ifdef PROBE_PREFIX
        const int nb = (P.flags & 16384) ? 2 : (j_hi - j_lo);
#else
        const int nb = j_hi - j_lo;
#endif
        const bool rot = (!smp) && (c >= 8); const int rsh = 8 - (c % 9) + 9;
#define ATT_J(i) (rot ? (2 * ((((i) >> 1) + rsh) % 9) + ((i) & 1)) : (j_lo + (i)))
        bf16x8 kf[4], vf[4];
#ifdef PROBE_PREFIX
        if (!(P.flags & 4)) {
#endif
        ATT_DMA(ATT_J(0), 0);
        if (1 < nb) ATT_DMA(ATT_J(1), 1);
#ifdef PROBE_PREFIX
        }
#endif
#pragma unroll
        for (int qb = 0; qb < 2; ++qb)
#pragma unroll
            for (int kk = 0; kk < 4; ++kk) asm volatile("" : "+v"(qf[qb][kk]));
        int sl = 0;
#pragma unroll 1
        for (int i = 0; i < nb; ++i) {
            if (i + 1 < nb) asm volatile("s_waitcnt vmcnt(8)" ::: "memory"); else asm volatile("s_waitcnt vmcnt(0)" ::: "memory");
            const LAS unsigned char* sp = ring + sl * 8192 + lane * 16;
#pragma unroll
            for (int kk = 0; kk < 4; ++kk) { kf[kk] = *(const LAS bf16x8*)(sp + kk * 1024); vf[kk] = *(const LAS bf16x8*)(sp + 4096 + kk * 1024); }
            asm volatile("s_waitcnt lgkmcnt(0)" ::: "memory");
#ifdef PROBE_PREFIX
            if (i + 2 < nb && !(P.flags & 4)) { const int j2 = ATT_J(i + 2); ATT_DMA(j2, sl); } else if (i + 2 == nb) { ATT_ZDMA(sl); zsl = sl; }
            const int j = ATT_J(i);
            if (!(P.flags & 8)) ATT_BODY(kf, vf, j);
#else
            if (i + 2 < nb) { const int j2 = ATT_J(i + 2); ATT_DMA(j2, sl); } else if (i + 2 == nb) { ATT_ZDMA(sl); zsl = sl; }
            const int j = ATT_J(i);
            ATT_BODY(kf, vf, j);
#endif
            sl ^= 1;
        }
#undef ATT_J
    }
#undef ATT_DMA
#undef ATT_BODY
    {
        const LAS unsigned char* zt = ring + zsl * 8192; LAS unsigned char* ot = ring + (zsl ^ 1) * 8192;
#pragma unroll
        for (int qb = 0; qb < 2; ++qb) {
            const float l = lsum[qb] + __shfl_xor(lsum[qb], 32); const float inv = __builtin_amdgcn_rcpf(l);
            const int tq = 32 * qb + l31;
#ifdef PROBE_PREFIX
            if (!(P.flags & 16))
#endif
#pragma unroll
            for (int dt = 0; dt < 2; ++dt)
#pragma unroll
                for (int rg = 0; rg < 4; ++rg) { const int cc = 4 * dt + rg; const int off = tq * 128 + ((cc ^ (tq & 7)) * 16) + 8 * hh;
                    const v2u zb = *(const LAS v2u*)(zt + off);
                    v2u o; o.x = pk2(oacc[qb][dt][4 * rg] * inv * siluf(bflo(zb.x)), oacc[qb][dt][4 * rg + 1] * inv * siluf(bfhi(zb.x)));
                    o.y = pk2(oacc[qb][dt][4 * rg + 2] * inv * siluf(bflo(zb.y)), oacc[qb][dt][4 * rg + 3] * inv * siluf(bfhi(zb.y)));
                    *(LAS v2u*)(ot + off) = o; }
        }
        bf16* mixb = (bf16*)(P.ws + WS_MIX) + m0u * 1024 + 512 + h * 64;
        const int tk = lane >> 3, ch = lane & 7;
#pragma unroll
        for (int p = 0; p < 8; ++p) { const int tok = 8 * p + tk;
            const v4u w = *(const LAS v4u*)(ot + tok * 128 + ((ch ^ (tok & 7)) * 16));
            if (!smp || tok < 16) *(v4u*)(mixb + (size_t)tok * 1024 + ch * 8) = w; }
        asm volatile("s_waitcnt lgkmcnt(0)" ::: "memory");
    }
}
constexpr int AG_R = 14, AG_D = 6;
__device__ __forceinline__ void attn_group(const Params& P, LAS unsigned char* lds, const LAS float* tabh, int s, int h, int c0, int wave, int lane) {
    const int pi = wave >> 1, qb = wave & 1, c = c0 + pi, l31 = lane & 31, hh = lane >> 5;
    const unsigned char* yscr = (const unsigned char*)P.out;
    const long kblk0 = (long)s * 256 + 2 * (c0 - 8);
    const unsigned char* src = yscr + (wave < 4 ? YO_KF : YO_VF) + (size_t)h * 4096 + (size_t)(wave & 3) * 1024 + lane * 16;
    LAS unsigned char* dstw = lds + (wave < 4 ? 0 : 4096) + (wave & 3) * 1024;
    const int pos_lo = (c0 < 8) ? 2 * (8 - c0) : 0;
    const bool fast = (c0 >= 8);
#ifdef PROBE_PREFIX
#define AG_BAR() do { asm volatile("" ::: "memory"); if (!(P.flags & 524288)) __builtin_amdgcn_s_barrier(); asm volatile("" ::: "memory"); } while (0)
#define AG_NODMA (P.flags & 262144)
#define AG_NOBODY (P.flags & 131072)
#else
#define AG_BAR() do { asm volatile("" ::: "memory"); __builtin_amdgcn_s_barrier(); asm volatile("" ::: "memory"); } while (0)
#define AG_NODMA 0
#define AG_NOBODY 0
#endif
    bf16x8 qf[4];
    { const unsigned char* qp = P.ws + WS_QF + ((size_t)(s * 256 + 2 * c + qb) * 8 + h) * 4096 + lane * 16;
#pragma unroll
      for (int kk = 0; kk < 4; ++kk) qf[kk] = *(const bf16x8*)(qp + kk * 1024);
#pragma unroll
      for (int kk = 0; kk < 4; ++kk) asm volatile("" : "+v"(qf[kk])); }
    f32x16 cbias;
    { const float bconst = tabh[256];
#pragma unroll
      for (int r = 0; r < 16; ++r) cbias[r] = bconst; }
    f32x16 oacc[2]; float lsum = 0.f;
#pragma unroll
    for (int dt = 0; dt < 2; ++dt)
#pragma unroll
        for (int r = 0; r < 16; ++r) oacc[dt][r] = 0.f;
#pragma unroll 1
    for (int p = 0; p <= 6 + AG_D; ++p) if (p >= pos_lo && !AG_NODMA) glds16_asm(src + (size_t)(kblk0 + p) * 32768, dstw + (p % AG_R) * 8192, false);
    asm volatile("s_waitcnt vmcnt(6)" ::: "memory"); (void)fast;
    AG_BAR();
#pragma unroll 1
    for (int t = 0; t < 18; ++t) {
        { const int pn = t + 7 + AG_D; if (pn < 24 && pn >= pos_lo && !AG_NODMA) glds16_asm(src + (size_t)(kblk0 + pn) * 32768, dstw + (pn % AG_R) * 8192, false); }
        const int p = 2 * pi + t;
        if (p >= pos_lo && !AG_NOBODY) {
            const LAS unsigned char* sp = lds + (p % AG_R) * 8192 + lane * 16;
            bf16x8 kf[4], vf[4];
#pragma unroll
            for (int kk = 0; kk < 4; ++kk) { kf[kk] = *(const LAS bf16x8*)(sp + kk * 1024); vf[kk] = *(const LAS bf16x8*)(sp + 4096 + kk * 1024); }
            const int kt = t >> 1, half = t & 1;
            f32x16 sa;
            if (kt <= 5) sa = mfma32(kf[0], qf[0], cbias);
            else { const LAS float* tp_ = tabh + (512 - 64 * kt - 32 * half + 32 * qb + l31 - 4 * hh + 128 - 27); f32x16 bi;
#pragma unroll
                for (int r = 0; r < 16; ++r) bi[r] = tp_[27 - ((r & 3) + 8 * (r >> 2))];
                sa = mfma32(kf[0], qf[0], bi); }
#pragma unroll
            for (int kk = 1; kk < 4; ++kk) sa = mfma32(kf[kk], qf[kk], sa);
            float pr[16];
#pragma unroll
            for (int r = 0; r < 16; ++r) pr[r] = __builtin_amdgcn_exp2f(sa[r]);
            { typedef float f32x2_ __attribute__((ext_vector_type(2))); f32x2_ a2 = {pr[0], pr[1]}, b2 = {pr[2], pr[3]};
#pragma unroll
              for (int r = 4; r < 16; r += 4) { a2 += (f32x2_){pr[r], pr[r + 1]}; b2 += (f32x2_){pr[r + 2], pr[r + 3]}; }
              a2 += b2; lsum += a2.x + a2.y; }
            v4u w0, w1; w0.x = pk2(pr[0], pr[1]); w0.y = pk2(pr[2], pr[3]); w0.z = pk2(pr[4], pr[5]); w0.w = pk2(pr[6], pr[7]); w1.x = pk2(pr[8], pr[9]); w1.y = pk2(pr[10], pr[11]); w1.z = pk2(pr[12], pr[13]); w1.w = pk2(pr[14], pr[15]);
            const bf16x8 pb0 = __builtin_bit_cast(bf16x8, w0), pb1 = __builtin_bit_cast(bf16x8, w1);
#pragma unroll
            for (int dt = 0; dt < 2; ++dt) { oacc[dt] = mfma32(vf[dt * 2 + 0], pb0, oacc[dt]); oacc[dt] = mfma32(vf[dt * 2 + 1], pb1, oacc[dt]); }
        }
        asm volatile("s_waitcnt lgkmcnt(0)" ::: "memory");
        if (t + 7 + AG_D < 24) asm volatile("s_waitcnt vmcnt(6)" ::: "memory"); else asm volatile("s_waitcnt vmcnt(0)" ::: "memory");
        AG_BAR();
    }
#undef AG_BAR
    {
        const float l = lsum + __shfl_xor(lsum, 32); const float inv = __builtin_amdgcn_rcpf(l);
        const size_t mrow0 = (size_t)s * TP + c * 64 + 32 * qb;
        const bf16* Z = (const bf16*)(P.ws + WS_Z) + mrow0 * 1024 + 512 + h * 64; bf16* MIX = (bf16*)(P.ws + WS_MIX) + mrow0 * 1024 + 512 + h * 64;
        const int rr = lane >> 3, pc = lane & 7;
        v4u zb[4];
#pragma unroll
        for (int ps = 0; ps < 4; ++ps) zb[ps] = *(const v4u*)(Z + (size_t)(8 * ps + rr) * 1024 + 8 * pc);
        LAS unsigned char* st = lds + wave * 14336;
#pragma unroll
        for (int dt = 0; dt < 2; ++dt)
#pragma unroll
            for (int rg = 0; rg < 4; ++rg) { const f32x4 o = {oacc[dt][4 * rg] * inv, oacc[dt][4 * rg + 1] * inv, oacc[dt][4 * rg + 2] * inv, oacc[dt][4 * rg + 3] * inv};
                *(LAS f32x4*)(st + l31 * 272 + (32 * dt + 8 * rg + 4 * hh) * 4) = o; }
#pragma unroll
        for (int ps = 0; ps < 4; ++ps) { const int row = 8 * ps + rr;
            const f32x4 a = *(const LAS f32x4*)(st + row * 272 + pc * 32), b = *(const LAS f32x4*)(st + row * 272 + pc * 32 + 16);
            float z[8]; unpack8(zb[ps], z);
            float f[8] = {a[0] * siluf(z[0]), a[1] * siluf(z[1]), a[2] * siluf(z[2]), a[3] * siluf(z[3]), b[0] * siluf(z[4]), b[1] * siluf(z[5]), b[2] * siluf(z[6]), b[3] * siluf(z[7])};
            *(v4u*)(MIX + (size_t)row * 1024 + 8 * pc) = packf8(f); }
    }
}
template <int RT, class F>
__device__ __forceinline__ void sample_gemm_task(const bf16* A, const bf16* Bt, int K, int ct, int row0, int lane, F f) {
    const int l15 = lane & 15, q4 = lane >> 4;
    f32x4 acc[RT];
#pragma unroll
    for (int rt = 0; rt < RT; ++rt) acc[rt] = (f32x4){0.f, 0.f, 0.f, 0.f};
    const bf16* bp = Bt + (size_t)(16 * ct + l15) * K + 8 * q4;
    const bf16* ap = A + (size_t)(row0 + l15) * K + 8 * q4;
#pragma unroll 8
    for (int ks = 0; ks < K / 32; ++ks) { const bf16x8 b = *(const bf16x8*)(bp + 32 * ks);
#pragma unroll
        for (int rt = 0; rt < RT; ++rt) { const bf16x8 a = *(const bf16x8*)(ap + (size_t)(16 * rt) * K + 32 * ks); acc[rt] = mfma16(a, b, acc[rt]); } }
#pragma unroll
    for (int rt = 0; rt < RT; ++rt)
#pragma unroll
        for (int r = 0; r < 4; ++r) f(row0 + 16 * rt + 4 * q4 + r, 16 * ct + l15, acc[rt][r]);
}
struct SEpiProj { bf16* qkva; bf16* qkvb; bf16* z;
    __device__ __forceinline__ void operator()(int row, int n, float v) const { const size_t m = (size_t)MP + row; const bf16 b = (bf16)(pk2(v, 0.f) & 0xffffu);
        if (n < 1536) qkva[m * 1536 + n] = b; else if (n < 3072) qkvb[m * 1536 + (n - 1536)] = b; else z[m * 1024 + (n - 3072)] = b; } };
struct SEpiOut { const float* xs; bf16* h1b;
    __device__ __forceinline__ void operator()(int row, int n, float v) const { const size_t m = (size_t)MP + row; const float h = xs[(size_t)row * 1024 + n] + v; h1b[m * 1024 + n] = (bf16)(pk2(h, 0.f) & 0xffffu); } };
struct SEpiE { bf16* E; float* ssq;
    __device__ __forceinline__ void operator()(int row, int n, float v) const { const size_t m = (size_t)MP + row; E[m * 1024 + n] = (bf16)(pk2(v, 0.f) & 0xffffu);
        float s = v * v; s += __shfl_xor(s, 1); s += __shfl_xor(s, 2); s += __shfl_xor(s, 4); s += __shfl_xor(s, 8);
        if ((threadIdx.x & 15) == 0) atomicAdd(ssq + m, s); } };
struct SEpiGate { float* y; const bf16* h1b; const bf16* E; const float* ssq; const float* pg;
    __device__ __forceinline__ void operator()(int row, int n, float v) const { const size_t m = (size_t)MP + row; const float rstd = 1.0f / sqrtf(ssq[m] * (1.0f / 1024.0f) + 1e-6f);
        const float sg = __builtin_amdgcn_rcpf(1.0f + __expf(-v)); y[m * 1024 + n] = bf1(h1b[m * 1024 + n]) + sg * (bf1(E[m * 1024 + n]) * rstd * pg[n]); } };
__device__ __forceinline__ void gate_tile(const Params& P, int tile, int lane) {
    const int l15 = lane & 15, q4 = lane >> 4;
    const bf16* ap = (const bf16*)(P.ws + WS_XN) + (size_t)(16 * tile + l15) * 1024 + 8 * q4;
    const bf16* bp = (const bf16*)(P.ws + WS_WAB) + (size_t)l15 * 1024 + 8 * q4;
    f32x4 acc = {0.f, 0.f, 0.f, 0.f};
#pragma unroll 16
    for (int ks = 0; ks < 32; ++ks) acc = mfma16(*(const bf16x8*)(ap + 32 * ks), *(const bf16x8*)(bp + 32 * ks), acc);
    float* Gd = (float*)(P.ws + WS_G); float* Bd = (float*)(P.ws + WS_BETA);
    const int c = l15;
    const float al = (c < 8) ? -expf(P.a_log[c]) : 0.f, db = (c < 8) ? P.dt_bias[c] : 0.f;
#pragma unroll
    for (int r = 0; r < 4; ++r) { const size_t mrow = (size_t)16 * tile + 4 * q4 + r; const float v = acc[r];
        if (c < 8) { const float xx = v + db; const float sp = xx > 20.f ? xx : log1pf(expf(xx)); Gd[mrow * 8 + c] = al * sp; }
        else Bd[mrow * 8 + (c - 8)] = 1.0f / (1.0f + expf(-v)); }
}
__device__ __forceinline__ void phase4(const Params& P, int lane, int wave, int G) {
    const int gw = blockIdx.x * NWAVES + wave, NGW = G * NWAVES;
    const float* OA = (const float*)((const unsigned char*)P.out + YO_OA); const float* OAS = (const float*)(P.ws + WS_OAS);
    const bf16* Z = (const bf16*)(P.ws + WS_Z); bf16* MIX = (bf16*)(P.ws + WS_MIX);
    float gg[8];
#pragma unroll
    for (int i = 0; i < 8; ++i) gg[i] = P.gdn_g[(8 * lane + i) & 63];
    for (int m = gw; m < M; m += NGW) {
        const float* orow = m < MP ? OA + (size_t)m * 512 : OAS + (size_t)(m - MP) * 512;
        const f32x4 a = ((const f32x4*)orow)[2 * lane], b = ((const f32x4*)orow)[2 * lane + 1];
        float f[8] = {a[0], a[1], a[2], a[3], b[0], b[1], b[2], b[3]};
        float ss = 0.f;
#pragma unroll
        for (int i = 0; i < 8; ++i) ss += f[i] * f[i];
        ss += __shfl_xor(ss, 1); ss += __shfl_xor(ss, 2); ss += __shfl_xor(ss, 4);
        const float rstd = __builtin_amdgcn_rsqf(ss * (1.0f / 64.0f) + 1e-6f);
        const v4u zw = *(const v4u*)(Z + (size_t)m * 1024 + 8 * lane); float z[8]; unpack8(zw, z);
#pragma unroll
        for (int i = 0; i < 8; ++i) f[i] = f[i] * rstd * gg[i] * siluf(z[i]);
        *(v4u*)(MIX + (size_t)m * 1024 + 8 * lane) = packf8(f);
    }
}
constexpr int N_PHASES = 7;
__global__ void __launch_bounds__(NWAVES * 64, 2) fwd_kernel(Params P) {
    extern __shared__ __attribute__((aligned(16))) unsigned char lds_raw[];
    LAS unsigned char* lds = (LAS unsigned char*)lds_raw;
    volatile LAS unsigned* MISC = (volatile LAS unsigned*)(lds + MISC_OFF);
    const int G = gridDim.x;
#define PHASE_IDS int tid = threadIdx.x; asm volatile("" : "+v"(tid)); const int lane = tid & 63, wave = __builtin_amdgcn_readfirstlane(tid >> 6); (void)lane; (void)wave
    { PHASE_IDS;
    for (int u = tid; u < (LDS_BYTES - LDSCTL_OFF) / 4; u += NWAVES * 64) ((LAS unsigned*)(lds + LDSCTL_OFF))[u] = 0u; }
    __syncthreads();
    unsigned char* ws = P.ws;
    const int lo = P.ph_lo, hi = P.ph_hi;
    const bool multi = (hi - lo) > 1;
    XcdBarrier bar; bar.bar = (unsigned*)(ws + WS_CTL) + CW_BAR; bar.x = 0; bar.st = nullptr;
    if (multi) bar = xcd_barrier_post((unsigned*)(ws + WS_CTL) + CW_BAR, MISC + 8);
#ifndef PROBE_REP
#define PROBE_REP -1
#endif
#define IN(k) (lo <= (k) && (k) < hi)
#define REP(k) _Pragma("unroll") for (int rep_ = 0; rep_ < ((PROBE_REP == (k)) ? 2 : 1); ++rep_)
#define SEAM(k) do { if (IN(k) && IN((k) + 1)) xcd_barrier(bar); } while (0)
    if (IN(0)) REP(0) { PHASE_IDS; phase0(P, lds, tid, lane, wave, G); __syncthreads(); }
    SEAM(0);
    if (IN(1)) REP(1) {
        int cls = (int)blockIdx.x & 3; asm volatile("" : "+s"(cls));
#pragma unroll 1
        for (int st = 0; st < 3; ++st) {
            if (st == 1) {
                pg8::Gemm g{(const pg8::bf16_t*)(ws + WS_XN), (const pg8::bf16_t*)(ws + WS_WIN), MP, 4096, 1024}; pg8::StaticOrder S;
#ifdef PROBE_PREFIX
                S.init((P.flags & 1048576) ? MP / 4 : MP, 4096, G, (int)blockIdx.x);
#else
                S.init(MP, 4096, G, (int)blockIdx.x);
#endif
                pg8::EpiProj E{(pg8::bf16_t*)(ws + WS_QKVA), (pg8::bf16_t*)(ws + WS_QKVB), (pg8::bf16_t*)(ws + WS_Z), lds + pg8::XCHG_OFF};
                pg8::gemm_phase<pg8::EpiProj, pg8::StaticOrder, PG8_ALIGN, PG8_SP2>(lds, g, S, E);
            } else { PHASE_IDS;
                const int mask = (st == 0) ? cls : 3 - cls;
                if (mask & 1) for (int tl = (int)blockIdx.x * NWAVES + wave; tl < M / 16; tl += G * NWAVES) gate_tile(P, tl, lane);
                if (mask & 2) for (int ct = blockIdx.x; ct < 256; ct += G)
                    sample_gemm_task<2>((const bf16*)(ws + WS_XN) + (size_t)MP * 1024, (const bf16*)(ws + WS_WIN), 1024, ct, 32 * wave, lane, SEpiProj{(bf16*)(ws + WS_QKVA), (bf16*)(ws + WS_QKVB), (bf16*)(ws + WS_Z)});
                __syncthreads();
            }
        }
    }
    SEAM(1);
    if (IN(2)) REP(2) { PHASE_IDS;
        if (!(P.flags & 32)) REP(20) { gdn_prep_all(P, lds, tid, lane, wave, G);
        __syncthreads(); }
        if (!(P.flags & 64)) REP(21) for (int it = (G - 1 - (int)blockIdx.x); it < NCU + NBS * 8; it += G) bprep_item(P, lds, it, tid, lane, wave);
        conv_state_out(P, tid, G);
    }
    SEAM(2);
    if (IN(3)) REP(3) { PHASE_IDS;
        const int NSC = 64;
        if ((int)blockIdx.x < NSC && !(P.flags & 1)) {
            { const int pr = (int)blockIdx.x * 2 + (wave >> 2); scan_chain(P, true, pr >> 3, pr & 7, wave & 3, lane); }
            asm volatile("s_waitcnt vmcnt(0)" ::: "memory"); __syncthreads();
            {
                const int pr = (int)blockIdx.x * 2 + (tid >> 8), sp = pr >> 3, hp_ = pr & 7, t = (tid >> 4) & 15, part = tid & 15;
                const size_t row = (size_t)sp * 16 + t;
                const f32x4 o4 = *(const f32x4*)((const float*)(ws + WS_OAS) + row * 512 + hp_ * 64 + 4 * part);
                float ss = (o4[0] * o4[0] + o4[1] * o4[1]) + (o4[2] * o4[2] + o4[3] * o4[3]);
                ss += __shfl_xor(ss, 1); ss += __shfl_xor(ss, 2); ss += __shfl_xor(ss, 4); ss += __shfl_xor(ss, 8);
                const float rstd = __builtin_amdgcn_rsqf(ss * (1.0f / 64.0f) + 1e-6f);
                const size_t mo = ((size_t)MP + row) * 1024 + hp_ * 64 + 4 * part;
                const v2u zb = *(const v2u*)((const bf16*)(ws + WS_Z) + mo);
                const f32x4 g4 = *(const f32x4*)(P.gdn_g + 4 * part);
                v2u o; o.x = pk2(o4[0] * rstd * g4[0] * siluf(bflo(zb.x)), o4[1] * rstd * g4[1] * siluf(bfhi(zb.x))); o.y = pk2(o4[2] * rstd * g4[2] * siluf(bflo(zb.y)), o4[3] * rstd * g4[3] * siluf(bfhi(zb.y)));
                *(v2u*)((bf16*)(ws + WS_MIX) + mo) = o;
            }
            __syncthreads();
            REP(30) { scan_prompt_wg(P, lds, (int)blockIdx.x >> 3, (int)blockIdx.x & 7, wave, lane); __syncthreads(); }
            __syncthreads();
        }
        attn_setup(P, lds, tid);
#ifdef PROBE_PREFIX
        if (P.flags & 32768) {
            f32x4 acc = {0.f, 0.f, 0.f, 0.f}; bf16x8 a = {1, 2, 3, 4, 5, 6, 7, 8}, b = {1, 1, 1, 1, 1, 1, 1, 1};
            for (int i = 0; i < 20000; ++i) acc = mfma16(a, b, acc);
            if (acc[0] == 123.456f) ((float*)(ws + WS_OAS))[tid] = acc[0];
        }
        if (P.flags & 65536) {
            float x = (float)tid * 1e-9f;
            for (int i = 0; i < 200000; ++i) x = __builtin_fmaf(x, 0.999f, 1e-7f);
            if (x == 123.456f) ((float*)(ws + WS_OAS))[tid] = x;
        }
#endif
        if (!(P.flags & 2)) REP(31) {
            unsigned* ctr = (unsigned*)(ws + WS_CTL) + CW_ATT + (rep_ ? 64 * 16 : 0);
            volatile LAS unsigned* tk = (volatile LAS unsigned*)(lds + TAB_OFF + 8 * TAB_LD * 4 + 64);
            unsigned nxt = 0;
            if (tid == 0) { tk[0] = __hip_atomic_fetch_add(ctr, 1u, __ATOMIC_RELAXED, __HIP_MEMORY_SCOPE_AGENT); nxt = __hip_atomic_fetch_add(ctr, 1u, __ATOMIC_RELAXED, __HIP_MEMORY_SCOPE_AGENT); }
            for (;;) {
                __syncthreads();
                const unsigned b = tk[0];
                __syncthreads();
                if (b >= 2064u) break;
#ifdef PROBE_PREFIX
                if (!(P.flags & 128))
#endif
                {
                if (b >= 16u) { const unsigned g = b - 16u; const int sq = (int)(g >> 8), h = (int)((g >> 5) & 7), c0 = 4 * (int)(g & 31);
                    attn_group(P, lds, (const LAS float*)(lds + TAB_OFF) + h * TAB_LD, sq, h, c0, wave, lane); }
                else attn_unit(P, (const LAS float*)(lds + TAB_OFF) + wave * TAB_LD, lds + wave * 16384, 1024 + (int)b, wave, lane);
                }
                if (tid == 0) { tk[0] = nxt; nxt = __hip_atomic_fetch_add(ctr, 1u, __ATOMIC_RELAXED, __HIP_MEMORY_SCOPE_AGENT); }
            }
        }
    }
    SEAM(3);
    if (IN(5)) { PHASE_IDS;
        const int QN = (G % 32 == 0) ? 4 : 1, nq = G / QN;
        int myq, myj; if (QN == 4) { const int x = (int)blockIdx.x & 7, l = (int)blockIdx.x >> 3; myq = x * (G / 32) + (l >> 2); myj = l & 3; } else { myq = blockIdx.x; myj = 0; }
        unsigned epi5 = 0;
        int cls5 = (int)blockIdx.x & 3; asm volatile("" : "+s"(cls5));
#pragma unroll 1
        for (int st5 = 0; st5 < 3; ++st5) {
            if (st5 == 1) {
            for (int grp = myq; grp < MP / 256 / QN; grp += nq) {
                int n4 = 4; asm volatile("" : "+s"(n4));
                const int pm0 = grp * QN, j0 = myj, dpm = QN == 4 ? 1 : 0, dpn = QN == 4 ? 0 : 1;
                const pg8::PanelOrder S{pm0, n4, j0, dpm, dpn};
                { pg8::Gemm g{(const pg8::bf16_t*)(ws + WS_MIX), (const pg8::bf16_t*)(ws + WS_WOUT), MP, 1024, 1024};
                  pg8::EpiOutB E{P.x_p, (pg8::bf16_t*)(ws + WS_H1B), lds + pg8::XCHG_OFF};
                  pg8::gemm_phase<pg8::EpiOutB, pg8::PanelOrder, PG8_ALIGN, PG8_SP2>(lds, g, S, E); }
                { int k256 = 256; asm volatile("" : "+s"(k256));
                  pg8::Gemm g{(const pg8::bf16_t*)(ws + WS_PB), (const pg8::bf16_t*)(ws + WS_WPLE), MP, 1024, k256};
                  pg8::EpiE E{(pg8::bf16_t*)(ws + WS_E), (float*)(ws + WS_SSQ), lds + pg8::XCHG_OFF};
                  pg8::gemm_phase<pg8::EpiE, pg8::PanelOrder, PG8_ALIGN, PG8_SP2>(lds, g, S, E); }
                asm volatile("s_waitcnt vmcnt(0)" ::: "memory"); __syncthreads();
                if (tid == 0) {
                    ++epi5;
                    if (QN == 4) { unsigned* qc = (unsigned*)(ws + WS_CTL) + CW_QD + 32 * myq; unsigned* bar = (unsigned*)(ws + WS_CTL) + CW_BAR;
                        __builtin_amdgcn_fence(__ATOMIC_RELEASE, "agent"); asm volatile("s_waitcnt vmcnt(0)" ::: "memory");
                        (void)xb_add(qc, 1u);
                        XB_SPIN(xb_ld(qc) < 4u * epi5, bar); }
                    __builtin_amdgcn_fence(__ATOMIC_ACQUIRE, "agent"); asm volatile("s_waitcnt vmcnt(0)" ::: "memory"); }
                __syncthreads();
                { pg8::Gemm g{(const pg8::bf16_t*)(ws + WS_H1B), (const pg8::bf16_t*)(ws + WS_WGATE), MP, 1024, 1024};
                  pg8::EpiGateB E{P.out + O_Y, (const pg8::bf16_t*)(ws + WS_H1B), (const pg8::bf16_t*)(ws + WS_E), (const float*)(ws + WS_SSQ), P.ple_g, lds + pg8::XCHG_OFF};
                  pg8::gemm_phase<pg8::EpiGateB, pg8::PanelOrder, PG8_ALIGN, PG8_SP2>(lds, g, S, E); }
            }
            } else { const int mask5 = (st5 == 0) ? cls5 : 3 - cls5;
            if (wave < 4) for (int tk = blockIdx.x; tk < 256; tk += G) {
                if (mask5 & 2) sample_gemm_task<1>((const bf16*)(ws + WS_MIX) + (size_t)MP * 1024, (const bf16*)(ws + WS_WOUT), 1024, tk & 63, 64 * (tk >> 6) + 16 * wave, lane, SEpiOut{P.x_s, (bf16*)(ws + WS_H1B)});
                if (mask5 & 1) sample_gemm_task<1>((const bf16*)(ws + WS_PB) + (size_t)MP * 256, (const bf16*)(ws + WS_WPLE), 256, tk & 63, 64 * (tk >> 6) + 16 * wave, lane, SEpiE{(bf16*)(ws + WS_E), (float*)(ws + WS_SSQ)}); }
                __syncthreads();
            }
        }
    }
    SEAM(5);
    if (IN(6)) { PHASE_IDS;
        if (wave < 4) for (int tk = blockIdx.x; tk < 256; tk += G)
            sample_gemm_task<1>((const bf16*)(ws + WS_H1B) + (size_t)MP * 1024, (const bf16*)(ws + WS_WGATE), 1024, tk & 63, 64 * (tk >> 6) + 16 * wave, lane, SEpiGate{P.out + O_Y, (const bf16*)(ws + WS_H1B), (const bf16*)(ws + WS_E), (const float*)(ws + WS_SSQ), P.ple_g});
    }
#undef IN
#undef SEAM
}

extern "C" void kernel_launch(void* const* d_in, const int* in_sizes, int n_in, void* d_out, int out_size, void* d_ws, size_t ws_size, hipStream_t stream) {
    static int grid = 0;
    if (grid == 0) {
        if (n_in != 21 || (size_t)out_size != O_END || ws_size < WS_END) { fprintf(stderr, "kernel_launch: unexpected shapes: n_in %d out %d ws %zu (need %zu); nothing launched\n", n_in, out_size, ws_size, (size_t)WS_END); grid = -1; return; }
        int dev = 0, cus = 0, per_cu = 0;
        if (hipGetDevice(&dev) != hipSuccess || hipDeviceGetAttribute(&cus, hipDeviceAttributeMultiprocessorCount, dev) != hipSuccess) { grid = -1; return; }
        if (hipFuncSetAttribute((const void*)fwd_kernel, hipFuncAttributeMaxDynamicSharedMemorySize, LDS_BYTES) != hipSuccess) { fprintf(stderr, "kernel_launch: hipFuncSetAttribute failed\n"); grid = -1; return; }
        if (hipOccupancyMaxActiveBlocksPerMultiprocessor(&per_cu, (const void*)fwd_kernel, NWAVES * 64, LDS_BYTES) != hipSuccess || per_cu < 1) { fprintf(stderr, "kernel_launch: occupancy query says %d blocks per CU\n", per_cu); }
        (void)hipGetLastError();
        grid = cus;
        if (grid < 128) { fprintf(stderr, "kernel_launch: %d CUs: too few\n", grid); grid = -1; return; }
    }
    if (grid < 0) return;
    if (hipMemsetAsync((char*)d_ws + WS_CTL, 0, CTL_ZERO_BYTES, stream) != hipSuccess) { fprintf(stderr, "kernel_launch: memset failed\n"); return; }
    Params p{};
    const float** pin = (const float**)&p;
    for (int i = 0; i < 21; ++i) pin[i] = (const float*)d_in[i];
    p.out = (float*)d_out; p.ws = (unsigned char*)d_ws;
#if MK_N_LAUNCHES == 1
#ifdef PROBE_PREFIX
    { p.ph_lo = 0; p.ph_hi = PROBE_PREFIX;
#ifdef PROBE_FLAGS
      p.flags = PROBE_FLAGS;
#endif
      void* a0[] = {&p}; (void)hipLaunchCooperativeKernel((const void*)fwd_kernel, dim3(grid), dim3(NWAVES * 64), a0, LDS_BYTES, stream);
      (void)hipMemsetAsync((char*)d_ws + WS_CTL, 0, CTL_ZERO_BYTES, stream); }
#endif
    p.ph_lo = 0; p.ph_hi = N_PHASES; p.flags = 0;
    void* args[] = {&p};
    hipError_t e = hipLaunchCooperativeKernel((const void*)fwd_kernel, dim3(grid), dim3(NWAVES * 64), args, LDS_BYTES, stream);
    if (e != hipSuccess) fprintf(stderr, "kernel_launch: cooperative launch failed: %s (grid %d)\n", hipGetErrorString(e), grid);
#else
    for (int k = 0; k < N_PHASES; ++k) { p.ph_lo = k; p.ph_hi = k + 1;
        hipLaunchKernelGGL(fwd_kernel, dim3(grid), dim3(NWAVES * 64), LDS_BYTES, stream, p);
        const hipError_t le = hipPeekAtLastError(); if (le != hipSuccess) { fprintf(stderr, "kernel_launch: launch %d failed: %s\n", k, hipGetErrorName(le)); break; } }
#endif
}
```
